# Optimizing an MI355X kernel written in HIP

```python
import jax, jax.numpy as jnp
from jax import lax
import numpy as np

D_MODEL = 1024
BATCH = 8
SEQ = 2048
DEPTH = 1

RET_HEADS = 4
RET_DK = 256
RET_DV = 256
RET_CHUNK = 128
MLA_HEADS = 8
MLA_NOPE = 128
MLA_ROPE = 64
MLA_V = 128
MLA_Q_LORA = 384
MLA_KV_LORA = 256
ATTN_BLOCK = 128
ROPE_THETA = 10000.0
N_GROUPS = 4
EXPERTS_PER_GROUP = 8
TOP_K = 2
D_EXPERT = 256
EPS = 1e-6

RET_QK_W = RET_HEADS * RET_DK
RET_V_W = RET_HEADS * RET_DV
MLA_V_W = MLA_HEADS * MLA_V
SPLITS = [RET_QK_W, RET_QK_W, RET_V_W, RET_V_W, MLA_Q_LORA, MLA_KV_LORA, MLA_ROPE, D_MODEL, D_MODEL]
IN_W = sum(SPLITS)

kernel_name = "hybrid_retention_mla_hiermoe_adaln"


def rmsnorm(x, g):
    xf = x.astype(jnp.float32)
    y = xf * lax.rsqrt(jnp.mean(xf * xf, axis=-1, keepdims=True) + EPS)
    return (y * g.astype(jnp.float32)).astype(x.dtype)


def modulate(x, shift, scale):
    return x * (1.0 + scale) + shift


def rope_tables(pos, dim):
    inv = ROPE_THETA ** (-jnp.arange(0, dim, 2, dtype=jnp.float32) / dim)
    ang = pos[:, None] * inv[None, :]
    return jnp.cos(ang), jnp.sin(ang)


def apply_rope(x, cos, sin):
    x1, x2 = jnp.split(x.astype(jnp.float32), 2, axis=-1)
    cos = cos[None, :, None, :]
    sin = sin[None, :, None, :]
    return jnp.concatenate([x1 * cos - x2 * sin, x2 * cos + x1 * sin], axis=-1).astype(x.dtype)


def retention(q, k, v):
    b, s, h, dk = q.shape
    dv = v.shape[-1]
    c = RET_CHUNK
    n = s // c
    log_gamma = jnp.log1p(-jnp.exp2(-5.0 - jnp.arange(h, dtype=jnp.float32)))
    idx = jnp.arange(c, dtype=jnp.float32)
    rel = idx[:, None] - idx[None, :]
    decay_in = jnp.where(rel[None] >= 0, jnp.exp(log_gamma[:, None, None] * jnp.maximum(rel, 0.0)[None]), 0.0)
    xi = jnp.exp(log_gamma[:, None] * (idx[None, :] + 1.0))
    zeta = jnp.exp(log_gamma[:, None] * (c - 1.0 - idx[None, :]))
    chunk_decay = jnp.exp(log_gamma * c)

    def to_chunks(t):
        return t.astype(jnp.float32).reshape(b, n, c, h, t.shape[-1]).transpose(1, 0, 2, 3, 4)

    qc = to_chunks(q)
    kc = to_chunks(k) * (dk ** -0.5)
    vc = to_chunks(v)

    def step(state, inp):
        qi, ki, vi = inp
        scores = jnp.einsum('bihd,bjhd->bhij', qi, ki) * decay_in[None]
        y = jnp.einsum('bhij,bjhe->bihe', scores, vi) + jnp.einsum('bihd,hi,bhde->bihe', qi, xi, state)
        state = state * chunk_decay[None, :, None, None] + jnp.einsum('bjhd,hj,bjhe->bhde', ki, zeta, vi)
        return state, y

    state0 = jnp.zeros((b, h, dk, dv), jnp.float32)
    _, ys = lax.scan(step, state0, (qc, kc, vc))
    return ys.transpose(1, 0, 2, 3, 4).reshape(b, s, h, dv)


def head_norm(y):
    mu = jnp.mean(y, axis=-1, keepdims=True)
    var = jnp.mean(jnp.square(y - mu), axis=-1, keepdims=True)
    return (y - mu) * lax.rsqrt(var + EPS)


def mla(c_q, c_kv, k_pe, q_norm, kv_norm, w_uq, w_ukv, cos, sin):
    b, s, _ = c_q.shape
    q = (rmsnorm(c_q, q_norm) @ w_uq).reshape(b, s, MLA_HEADS, MLA_NOPE + MLA_ROPE)
    q_nope, q_pe = q[..., :MLA_NOPE], q[..., MLA_NOPE:]
    q_pe = apply_rope(q_pe, cos, sin)
    kv = (rmsnorm(c_kv, kv_norm) @ w_ukv).reshape(b, s, MLA_HEADS, MLA_NOPE + MLA_V)
    k_nope, v = kv[..., :MLA_NOPE], kv[..., MLA_NOPE:]
    k_pe = apply_rope(k_pe[:, :, None, :], cos, sin)[:, :, 0, :]
    scale = (MLA_NOPE + MLA_ROPE) ** -0.5
    outs = []
    for blk in range(s // ATTN_BLOCK):
        lo = blk * ATTN_BLOCK
        hi = lo + ATTN_BLOCK
        scores = (jnp.einsum('bqhd,bkhd->bhqk', q_nope[:, lo:hi], k_nope[:, :hi])
                  + jnp.einsum('bqhr,bkr->bhqk', q_pe[:, lo:hi], k_pe[:, :hi])).astype(jnp.float32) * scale
        mask = (lo + jnp.arange(ATTN_BLOCK))[:, None] >= jnp.arange(hi)[None, :]
        p = jax.nn.softmax(jnp.where(mask, scores, -jnp.inf), axis=-1).astype(v.dtype)
        outs.append(jnp.einsum('bhqk,bkhd->bqhd', p, v[:, :hi]))
    return jnp.concatenate(outs, axis=1).reshape(b, s, MLA_V_W)


def token_mixer(u, w_in, w_ret_o, q_norm, kv_norm, w_uq, w_ukv, w_mla_o, w_out, ret_rope, mla_rope):
    b, s, _ = u.shape
    proj = u @ w_in
    offs = np.cumsum(SPLITS)[:-1].tolist()
    rq, rk, rv, rg, c_q, c_kv, k_pe, gate_ret, gate_mla = jnp.split(proj, offs, axis=-1)
    rq = apply_rope(rq.reshape(b, s, RET_HEADS, RET_DK), *ret_rope)
    rk = apply_rope(rk.reshape(b, s, RET_HEADS, RET_DK), *ret_rope)
    rv = rv.reshape(b, s, RET_HEADS, RET_DV)
    y_ret = head_norm(retention(rq, rk, rv)).reshape(b, s, RET_V_W).astype(u.dtype)
    y_ret = (jax.nn.silu(rg) * y_ret) @ w_ret_o
    y_mla = mla(c_q, c_kv, k_pe, q_norm, kv_norm, w_uq, w_ukv, *mla_rope) @ w_mla_o
    merged = jax.nn.sigmoid(gate_ret) * y_ret + jax.nn.sigmoid(gate_mla) * y_mla
    return merged @ w_out


def hier_moe(u, w_grp, b_grp, w_exp, b_exp, w1, w3, w2):
    b, s, d = u.shape
    t = u.reshape(-1, d)
    n_tok = t.shape[0]
    grp_logits = (t @ w_grp).astype(jnp.float32) + b_grp.astype(jnp.float32)
    grp_prob = jax.nn.softmax(grp_logits, axis=-1)
    _, g_sel = lax.top_k(grp_logits, 1)
    p_grp = jnp.take_along_axis(grp_prob, g_sel, axis=-1)
    exp_logits = ((t @ w_exp).astype(jnp.float32) + b_exp.astype(jnp.float32)).reshape(n_tok, N_GROUPS, EXPERTS_PER_GROUP)
    in_grp = jnp.take_along_axis(exp_logits, g_sel[:, :, None], axis=1)[:, 0]
    top_val, top_idx = lax.top_k(in_grp, TOP_K)
    top_w = jax.nn.softmax(top_val, axis=-1) * p_grp
    exp_w = jnp.sum(jax.nn.one_hot(top_idx, EXPERTS_PER_GROUP, dtype=jnp.float32) * top_w[..., None], axis=1)
    gate = jax.nn.one_hot(g_sel[:, 0], N_GROUPS, dtype=jnp.float32)[:, :, None] * exp_w[:, None, :]
    out = jnp.zeros_like(t)
    for gi in range(N_GROUPS):
        hid = jax.nn.silu(jnp.einsum('td,edf->tef', t, w1[gi])) * jnp.einsum('td,edf->tef', t, w3[gi])
        hid = hid * gate[:, gi, :, None].astype(hid.dtype)
        out = out + jnp.einsum('tef,efd->td', hid, w2[gi])
    return out.reshape(b, s, d)


def setup_inputs(seed: int = 0) -> dict:
    key = jax.random.key(seed)
    ks = jax.random.split(key, 24)
    L = DEPTH
    G, E, F = N_GROUPS, EXPERTS_PER_GROUP, D_EXPERT

    def nrm(k, shape, fan_in, scale=1.0):
        return jax.random.normal(k, shape, jnp.float32) * (scale * fan_in ** -0.5)

    def gain(k, shape):
        return 1.0 + 0.02 * jax.random.normal(k, shape, jnp.float32)

    return {
        "x": jax.random.normal(ks[0], (BATCH, SEQ, D_MODEL), jnp.float32),
        "c": jax.random.normal(ks[1], (BATCH, D_MODEL), jnp.float32),
        "w_ada": nrm(ks[2], (L, D_MODEL, 6 * D_MODEL), D_MODEL, 0.5),
        "b_ada": 0.02 * jax.random.normal(ks[3], (L, 6 * D_MODEL), jnp.float32),
        "norm1": gain(ks[4], (L, D_MODEL)),
        "norm2": gain(ks[5], (L, D_MODEL)),
        "w_in": nrm(ks[6], (L, D_MODEL, IN_W), D_MODEL),
        "w_ret_o": nrm(ks[7], (L, RET_V_W, D_MODEL), RET_V_W),
        "q_norm": gain(ks[8], (L, MLA_Q_LORA)),
        "kv_norm": gain(ks[9], (L, MLA_KV_LORA)),
        "w_uq": nrm(ks[10], (L, MLA_Q_LORA, MLA_HEADS * (MLA_NOPE + MLA_ROPE)), MLA_Q_LORA),
        "w_ukv": nrm(ks[11], (L, MLA_KV_LORA, MLA_HEADS * (MLA_NOPE + MLA_V)), MLA_KV_LORA),
        "w_mla_o": nrm(ks[12], (L, MLA_V_W, D_MODEL), MLA_V_W),
        "w_out": nrm(ks[13], (L, D_MODEL, D_MODEL), D_MODEL),
        "w_grp": nrm(ks[14], (L, D_MODEL, G), D_MODEL),
        "b_grp": 0.01 * jax.random.normal(ks[15], (L, G), jnp.float32),
        "w_exp": nrm(ks[16], (L, D_MODEL, G * E), D_MODEL),
        "b_exp": 0.01 * jax.random.normal(ks[17], (L, G * E), jnp.float32),
        "w1": nrm(ks[18], (L, G, E, D_MODEL, F), D_MODEL),
        "w3": nrm(ks[19], (L, G, E, D_MODEL, F), D_MODEL),
        "w2": nrm(ks[20], (L, G, E, F, D_MODEL), F),
        "final_norm": gain(ks[21], (D_MODEL,)),
    }


def reference(x, c, w_ada, b_ada, norm1, norm2, w_in, w_ret_o, q_norm, kv_norm, w_uq, w_ukv, w_mla_o, w_out,
              w_grp, b_grp, w_exp, b_exp, w1, w3, w2, final_norm):
    s = x.shape[1]
    pos = jnp.arange(s, dtype=jnp.float32)
    ret_rope = rope_tables(pos, RET_DK)
    mla_rope = rope_tables(pos, MLA_ROPE)
    c_act = jax.nn.silu(c)
    h = x
    for l in range(DEPTH):
        mod = (c_act @ w_ada[l] + b_ada[l])[:, None, :]
        sh1, sc1, g1, sh2, sc2, g2 = jnp.split(mod, 6, axis=-1)
        u = modulate(rmsnorm(h, norm1[l]), sh1, sc1)
        h = h + g1 * token_mixer(u, w_in[l], w_ret_o[l], q_norm[l], kv_norm[l], w_uq[l], w_ukv[l],
                                 w_mla_o[l], w_out[l], ret_rope, mla_rope)
        u = modulate(rmsnorm(h, norm2[l]), sh2, sc2)
        h = h + g2 * hier_moe(u, w_grp[l], b_grp[l], w_exp[l], b_exp[l], w1[l], w3[l], w2[l])
    return rmsnorm(h, final_norm)
```

```cpp
#include <hip/hip_runtime.h>
#include <cstdint>
#include <cstdio>

typedef unsigned short bf16;
#define DEV __device__ __forceinline__

constexpr int D_MODEL = 1024, BATCH = 8, SEQ = 2048, M = BATCH * SEQ;
constexpr int RET_HEADS = 4, RET_DK = 256, RET_DV = 256;
constexpr int MLA_HEADS = 8, MLA_NOPE = 128, MLA_ROPE = 64, MLA_V = 128, MLA_Q_LORA = 384, MLA_KV_LORA = 256;
constexpr int N_GROUPS = 4, EPG = 8, D_EXPERT = 256;
constexpr int IN_W = 6848;
constexpr float EPS = 1e-6f;
constexpr int C_RQ = 0, C_RK = 1024, C_RV = 2048, C_RG = 3072, C_CQ = 4096, C_CKV = 4480, C_KPE = 4736, C_GR = 4800, C_GM = 5824;

constexpr size_t MiB = 1u << 20;
constexpr size_t WS_MOD = 1 * MiB;
constexpr size_t WS_RS_Q = 1 * MiB + 512 * 1024;
constexpr size_t WS_RS_KV = 1 * MiB + 640 * 1024;
constexpr size_t WS_ROPE_RET = 2 * MiB;
constexpr size_t WS_ROPE_MLA = 4 * MiB;
constexpr size_t WS_ROUTE = 6 * MiB;
constexpr size_t S0 = 32 * MiB, S1 = 64 * MiB, S2 = 96 * MiB, S3 = 128 * MiB, S4 = 160 * MiB, S5 = 192 * MiB, S6 = 224 * MiB;

DEV float bf2f(bf16 v) { return __uint_as_float((unsigned)v << 16); }
DEV bf16 f2bf(float f) { unsigned u = __float_as_uint(f); return (bf16)((u + 0x7fffu + ((u >> 16) & 1u)) >> 16); }
DEV float silu_f(float v) { return v / (1.f + __expf(-v)); }
DEV float sigmoid_f(float v) { return 1.f / (1.f + __expf(-v)); }
DEV float wave_sum(float v) {
#pragma unroll
    for (int o = 1; o < 64; o <<= 1) v += __shfl_xor(v, o);
    return v;
}

__global__ void k_tables(float* ret_cs, float* mla_cs) {
    int idx = blockIdx.x * blockDim.x + threadIdx.x;
    if (idx < 2048 * 128) {
        int pos = idx / 128, i = idx % 128;
        float inv = (float)pow(10000.0, -(double)(2 * i) / 256.0);
        float ang = (float)pos * inv;
        ret_cs[idx] = (float)cos((double)ang); ret_cs[2048 * 128 + idx] = (float)sin((double)ang);
    }
    if (idx < 2048 * 32) {
        int pos = idx / 32, i = idx % 32;
        float inv = (float)pow(10000.0, -(double)(2 * i) / 64.0);
        float ang = (float)pos * inv;
        mla_cs[idx] = (float)cos((double)ang); mla_cs[2048 * 32 + idx] = (float)sin((double)ang);
    }
}

__global__ void k_mod(const float* c, const float* w_ada, const float* b_ada, float* mod) {
    int n = blockIdx.x * blockDim.x + threadIdx.x, b = blockIdx.y;
    float acc = 0.f;
    for (int k = 0; k < 1024; ++k) acc += silu_f(c[b * 1024 + k]) * w_ada[(size_t)k * 6144 + n];
    mod[b * 6144 + n] = acc + b_ada[n];
}

__global__ void k_normmod(const float* in, const float* gain, const float* mod, int sh_off, int sc_off, bf16* out) {
    int row = blockIdx.x * (blockDim.x / 64) + threadIdx.x / 64, lane = threadIdx.x & 63;
    int b = row / SEQ;
    const float* r = in + (size_t)row * 1024;
    float v[16]; float ss = 0.f;
#pragma unroll
    for (int i = 0; i < 16; ++i) { v[i] = r[lane + 64 * i]; ss += v[i] * v[i]; }
    ss = wave_sum(ss);
    float rs = rsqrtf(ss * (1.f / 1024.f) + EPS);
#pragma unroll
    for (int i = 0; i < 16; ++i) { int col = lane + 64 * i;
        float y = v[i] * rs * gain[col];
        y = y * (1.f + mod[b * 6144 + sc_off + col]) + mod[b * 6144 + sh_off + col];
        out[(size_t)row * 1024 + col] = f2bf(y); }
}

struct Epi {
    int mode;
    bf16* out; int ldc;
    const float* rs;
    const bf16* t1;
    const float* x; const float* mod; int g_off; float* outf;
};
__global__ void __launch_bounds__(256) k_gemm(const bf16* A, int lda, const float* W, int ldw, const float* kgain, int K, Epi e) {
    __shared__ float As[16][65]; __shared__ float Bs[16][64];
    int t = threadIdx.x, tx = t % 16, ty = t / 16;
    int m0 = blockIdx.y * 64, n0 = blockIdx.x * 64;
    float acc[4][4] = {};
    for (int k0 = 0; k0 < K; k0 += 16) {
#pragma unroll
        for (int i = 0; i < 4; ++i) { int idx = t + 256 * i; int r = idx / 16, kk = idx % 16; As[kk][r] = bf2f(A[(size_t)(m0 + r) * lda + k0 + kk]); }
#pragma unroll
        for (int i = 0; i < 4; ++i) { int idx = t + 256 * i; int kk = idx / 64, n = idx % 64; float w = W[(size_t)(k0 + kk) * ldw + n0 + n]; if (kgain) w *= kgain[k0 + kk]; Bs[kk][n] = w; }
        __syncthreads();
#pragma unroll
        for (int kk = 0; kk < 16; ++kk) { float a[4], b[4];
#pragma unroll
            for (int i = 0; i < 4; ++i) { a[i] = As[kk][ty * 4 + i]; b[i] = Bs[kk][tx * 4 + i]; }
#pragma unroll
            for (int i = 0; i < 4; ++i)
#pragma unroll
                for (int j = 0; j < 4; ++j) acc[i][j] += a[i] * b[j]; }
        __syncthreads();
    }
#pragma unroll
    for (int i = 0; i < 4; ++i)
#pragma unroll
        for (int j = 0; j < 4; ++j) { int m = m0 + ty * 4 + i, n = n0 + tx * 4 + j; float v = acc[i][j]; size_t o = (size_t)m * e.ldc + n;
            switch (e.mode) {
                case 0: e.out[o] = f2bf(v); break;
                case 1: e.out[o] = f2bf(silu_f(v)); break;
                case 2: e.out[o] = f2bf(sigmoid_f(v)); break;
                case 3: e.out[o] = f2bf(v * e.rs[m]); break;
                case 4: e.out[o] = f2bf(bf2f(e.out[o]) * v); break;
                case 5: e.out[o] = f2bf(bf2f(e.t1[o]) + bf2f(e.out[o]) * v); break;
                case 6: e.outf[o] = e.x[o] + e.mod[(m / SEQ) * 6144 + e.g_off + n] * v; break;
            } }
}

__global__ void k_rowscale(const bf16* A, int W, float* rs) {
    int row = blockIdx.x * (blockDim.x / 64) + threadIdx.x / 64, lane = threadIdx.x & 63;
    float ss = 0.f;
    for (int c = lane; c < W; c += 64) { float v = bf2f(A[(size_t)row * W + c]); ss += v * v; }
    ss = wave_sum(ss);
    if (lane == 0) rs[row] = rsqrtf(ss / (float)W + EPS);
}

__global__ void k_rope(bf16* buf, int ld, int col0, int hstride, int nheads, int HALF, const float* cs, float scale) {
    size_t idx = (size_t)blockIdx.x * blockDim.x + threadIdx.x;
    size_t total = (size_t)M * nheads * HALF;
    if (idx >= total) return;
    int i = idx % HALF; int h = (idx / HALF) % nheads; int m = idx / ((size_t)HALF * nheads);
    int pos = m % SEQ;
    float c = cs[pos * HALF + i], s = cs[2048 * HALF + pos * HALF + i];
    bf16* p = buf + (size_t)m * ld + col0 + h * hstride;
    float x1 = bf2f(p[i]), x2 = bf2f(p[i + HALF]);
    p[i] = f2bf((x1 * c - x2 * s) * scale); p[i + HALF] = f2bf((x2 * c + x1 * s) * scale);
}

template <int DQK, int DV, int MODE>
__global__ void __launch_bounds__(256) k_attn(const bf16* Q, const bf16* K1, const bf16* K2, const bf16* V, bf16* O) {
    __shared__ bf16 qs[32][DQK + 2]; __shared__ bf16 ks[32][DQK + 2]; __shared__ bf16 vs[32][DV];
    __shared__ float ss[32][33]; __shared__ float m_s[32], l_s[32], al_s[32];
    const int t = threadIdx.x, qt = blockIdx.x, h = blockIdx.y, b = blockIdx.z;
    const size_t row0 = (size_t)b * SEQ + qt * 32;
    constexpr int RPT = (32 * DV) / 256;
    const int col = t % DV, rbase = (t / DV) * RPT;
    float acc[RPT];
#pragma unroll
    for (int i = 0; i < RPT; ++i) acc[i] = 0.f;
    for (int idx = t; idx < 32 * DQK; idx += 256) { int r = idx / DQK, d = idx % DQK;
        qs[r][d] = (MODE == 0) ? Q[(row0 + r) * 1536 + h * 192 + d] : Q[(row0 + r) * 1024 + h * 256 + d]; }
    if (t < 32) { m_s[t] = -INFINITY; l_s[t] = 0.f; }
    const float lg2 = (MODE == 1) ? log2f(1.f - exp2f(-5.f - (float)h)) : 0.f;
    const float scale = (MODE == 0) ? 0.07216878364870322f : 1.f;
    for (int kt = 0; kt <= qt; ++kt) {
        const size_t k0 = (size_t)b * SEQ + kt * 32;
        __syncthreads();
        for (int idx = t; idx < 32 * DQK; idx += 256) { int r = idx / DQK, d = idx % DQK;
            if (MODE == 0) ks[r][d] = (d < 128) ? K1[(k0 + r) * 2048 + h * 256 + d] : K2[(k0 + r) * 64 + d - 128];
            else ks[r][d] = K1[(k0 + r) * 1024 + h * 256 + d]; }
        for (int idx = t; idx < 32 * DV; idx += 256) { int r = idx / DV, d = idx % DV;
            vs[r][d] = (MODE == 0) ? V[(k0 + r) * 2048 + h * 256 + 128 + d] : V[(k0 + r) * 1024 + h * 256 + d]; }
        __syncthreads();
        { const int i = t / 8, j0 = (t % 8) * 4; float s[4] = {0.f, 0.f, 0.f, 0.f};
            for (int d = 0; d < DQK; ++d) { float qv = bf2f(qs[i][d]);
#pragma unroll
                for (int jj = 0; jj < 4; ++jj) s[jj] += qv * bf2f(ks[j0 + jj][d]); }
#pragma unroll
            for (int jj = 0; jj < 4; ++jj) { int ig = qt * 32 + i, jg = kt * 32 + j0 + jj; float v;
                if (MODE == 0) v = (jg <= ig) ? s[jj] * scale : -INFINITY;
                else v = (jg <= ig) ? s[jj] * exp2f(lg2 * (float)(ig - jg)) : 0.f;
                ss[i][j0 + jj] = v; } }
        __syncthreads();
        if (MODE == 0) {
            if (t < 32) { float mo = m_s[t], mx = -INFINITY;
                for (int j = 0; j < 32; ++j) mx = fmaxf(mx, ss[t][j]);
                float mn = fmaxf(mo, mx), alpha = __expf(mo - mn), sum = 0.f;
                for (int j = 0; j < 32; ++j) { float p = __expf(ss[t][j] - mn); ss[t][j] = p; sum += p; }
                l_s[t] = l_s[t] * alpha + sum; m_s[t] = mn; al_s[t] = alpha; }
            __syncthreads();
        }
#pragma unroll
        for (int i = 0; i < RPT; ++i) { float a = (MODE == 0) ? acc[i] * al_s[rbase + i] : acc[i];
            for (int j = 0; j < 32; ++j) a += ss[rbase + i][j] * bf2f(vs[j][col]);
            acc[i] = a; }
    }
    __syncthreads();
#pragma unroll
    for (int i = 0; i < RPT; ++i) { float v = (MODE == 0) ? acc[i] / l_s[rbase + i] : acc[i];
        if (MODE == 0) O[(row0 + rbase + i) * 1024 + h * 128 + col] = f2bf(v); else O[(row0 + rbase + i) * 1024 + h * 256 + col] = f2bf(v); }
}

__global__ void k_headnorm(bf16* YR, const bf16* RGs) {
    int w = blockIdx.x * (blockDim.x / 64) + threadIdx.x / 64, lane = threadIdx.x & 63;
    size_t base = (size_t)(w / 4) * 1024 + (w % 4) * 256;
    float v[4], s = 0.f;
#pragma unroll
    for (int i = 0; i < 4; ++i) { v[i] = bf2f(YR[base + lane + 64 * i]); s += v[i]; }
    float mu = wave_sum(s) * (1.f / 256.f), q = 0.f;
#pragma unroll
    for (int i = 0; i < 4; ++i) { v[i] -= mu; q += v[i] * v[i]; }
    float rstd = rsqrtf(wave_sum(q) * (1.f / 256.f) + EPS);
#pragma unroll
    for (int i = 0; i < 4; ++i) YR[base + lane + 64 * i] = f2bf(v[i] * rstd * bf2f(RGs[base + lane + 64 * i]));
}

struct Route { int e0, e1; float w0, w1; };
__global__ void k_u2route(const float* H, const float* gain, const float* mod, const float* w_grp, const float* b_grp, const float* w_exp, const float* b_exp, bf16* U2, Route* route) {
    int row = blockIdx.x * (blockDim.x / 64) + threadIdx.x / 64, lane = threadIdx.x & 63;
    int b = row / SEQ;
    const float* r = H + (size_t)row * 1024;
    float v[16]; float ss = 0.f;
#pragma unroll
    for (int i = 0; i < 16; ++i) { v[i] = r[lane + 64 * i]; ss += v[i] * v[i]; }
    ss = wave_sum(ss);
    float rs = rsqrtf(ss * (1.f / 1024.f) + EPS);
#pragma unroll
    for (int i = 0; i < 16; ++i) { int col = lane + 64 * i;
        float y = v[i] * rs * gain[col];
        y = y * (1.f + mod[b * 6144 + 4096 + col]) + mod[b * 6144 + 3072 + col];
        v[i] = y; U2[(size_t)row * 1024 + col] = f2bf(y); }
    float gl0, gl1, gl2, gl3, mine = 0.f;
    { float a0 = 0.f, a1 = 0.f, a2 = 0.f, a3 = 0.f;
#pragma unroll
        for (int i = 0; i < 16; ++i) { const float* wg = w_grp + (lane + 64 * i) * 4; a0 += v[i] * wg[0]; a1 += v[i] * wg[1]; a2 += v[i] * wg[2]; a3 += v[i] * wg[3]; }
        gl0 = wave_sum(a0) + b_grp[0]; gl1 = wave_sum(a1) + b_grp[1]; gl2 = wave_sum(a2) + b_grp[2]; gl3 = wave_sum(a3) + b_grp[3]; }
    for (int e = 0; e < 32; ++e) { float a = 0.f;
#pragma unroll
        for (int i = 0; i < 16; ++i) a += v[i] * w_exp[(lane + 64 * i) * 32 + e];
        a = wave_sum(a) + b_exp[e]; if (lane == e) mine = a; }
    {
        int gs = 0; float gm = gl0;
        if (gl1 > gm) { gm = gl1; gs = 1; } if (gl2 > gm) { gm = gl2; gs = 2; } if (gl3 > gm) { gm = gl3; gs = 3; }
        float den = __expf(gl0 - gm) + __expf(gl1 - gm) + __expf(gl2 - gm) + __expf(gl3 - gm);
        float pg = 1.f / den;
        int i0 = 0; float v0 = -INFINITY;
#pragma unroll
        for (int e = 0; e < 8; ++e) { float xv = __shfl(mine, gs * 8 + e); if (xv > v0) { v0 = xv; i0 = e; } }
        int i1 = 0; float v1 = -INFINITY;
#pragma unroll
        for (int e = 0; e < 8; ++e) { float xv = __shfl(mine, gs * 8 + e); if (e != i0 && xv > v1) { v1 = xv; i1 = e; } }
        float e1 = __expf(v1 - v0), inv = 1.f / (1.f + e1);
        if (lane == 0) { Route rt; rt.e0 = gs * 8 + i0; rt.e1 = gs * 8 + i1; rt.w0 = inv * pg; rt.w1 = e1 * inv * pg; route[row] = rt; }
    }
}

__global__ void __launch_bounds__(256) k_moe_final(const bf16* U2, const Route* route, const float* w1, const float* w3, const float* w2, const float* H, const float* mod, const float* fnorm, float* out) {
    __shared__ float us[1024]; __shared__ float hid[256]; __shared__ float red[4];
    int row = blockIdx.x, t = threadIdx.x, b = row / SEQ;
    for (int i = t; i < 1024; i += 256) us[i] = bf2f(U2[(size_t)row * 1024 + i]);
    Route rt = route[row];
    float o[4] = {0.f, 0.f, 0.f, 0.f};
    for (int k = 0; k < 2; ++k) {
        int e = k ? rt.e1 : rt.e0; float gw = k ? rt.w1 : rt.w0;
        const float* W1 = w1 + (size_t)e * 1024 * 256; const float* W3 = w3 + (size_t)e * 1024 * 256; const float* W2 = w2 + (size_t)e * 256 * 1024;
        __syncthreads();
        float a = 0.f, c = 0.f;
        for (int d = 0; d < 1024; ++d) { float u = us[d]; a += u * W1[(size_t)d * 256 + t]; c += u * W3[(size_t)d * 256 + t]; }
        hid[t] = bf2f(f2bf(silu_f(a) * c * gw));
        __syncthreads();
        for (int f = 0; f < 256; ++f) { float hv = hid[f];
#pragma unroll
            for (int i = 0; i < 4; ++i) o[i] += hv * W2[(size_t)f * 1024 + t + 256 * i]; }
    }
    float hv[4], ss = 0.f;
#pragma unroll
    for (int i = 0; i < 4; ++i) { int col = t + 256 * i; hv[i] = H[(size_t)row * 1024 + col] + mod[b * 6144 + 5120 + col] * o[i]; ss += hv[i] * hv[i]; }
    ss = wave_sum(ss);
    __syncthreads();
    if ((t & 63) == 0) red[t / 64] = ss;
    __syncthreads();
    float tot = red[0] + red[1] + red[2] + red[3];
    float rs = rsqrtf(tot * (1.f / 1024.f) + EPS);
#pragma unroll
    for (int i = 0; i < 4; ++i) { int col = t + 256 * i; out[(size_t)row * 1024 + col] = hv[i] * rs * fnorm[col]; }
}

extern "C" void kernel_launch(void* const* d_in, const int* in_sizes, int n_in, void* d_out, int out_size, void* d_ws, size_t ws_size, hipStream_t stream) {
    const float* x = (const float*)d_in[0]; const float* c = (const float*)d_in[1]; const float* w_ada = (const float*)d_in[2]; const float* b_ada = (const float*)d_in[3];
    const float* norm1 = (const float*)d_in[4]; const float* norm2 = (const float*)d_in[5]; const float* w_in = (const float*)d_in[6]; const float* w_ret_o = (const float*)d_in[7];
    const float* q_norm = (const float*)d_in[8]; const float* kv_norm = (const float*)d_in[9]; const float* w_uq = (const float*)d_in[10]; const float* w_ukv = (const float*)d_in[11];
    const float* w_mla_o = (const float*)d_in[12]; const float* w_out = (const float*)d_in[13]; const float* w_grp = (const float*)d_in[14]; const float* b_grp = (const float*)d_in[15];
    const float* w_exp = (const float*)d_in[16]; const float* b_exp = (const float*)d_in[17]; const float* w1 = (const float*)d_in[18]; const float* w3 = (const float*)d_in[19];
    const float* w2 = (const float*)d_in[20]; const float* fnorm = (const float*)d_in[21];
    unsigned char* ws = (unsigned char*)d_ws; float* out = (float*)d_out;
    float* MOD = (float*)(ws + WS_MOD); float* RSQ = (float*)(ws + WS_RS_Q); float* RSKV = (float*)(ws + WS_RS_KV);
    float* ROPE_RET = (float*)(ws + WS_ROPE_RET); float* ROPE_MLA = (float*)(ws + WS_ROPE_MLA); Route* ROUTE = (Route*)(ws + WS_ROUTE);
    bf16* XN = (bf16*)(ws + S0); bf16* RQ = (bf16*)(ws + S1); bf16* RK = (bf16*)(ws + S2); bf16* RV = (bf16*)(ws + S3);
    bf16* CQ = (bf16*)(ws + S4); bf16* CKV = (bf16*)(ws + S4 + 12 * MiB); bf16* KPE = (bf16*)(ws + S4 + 20 * MiB);
    bf16* YR = (bf16*)(ws + S5); bf16* RGs = (bf16*)(ws + S1);
    bf16* Qb = (bf16*)(ws + S1 + 0);   bf16* KVB = (bf16*)d_out;
    bf16* ATT = (bf16*)(ws + S6); bf16* GR = (bf16*)(ws + S1); bf16* GM = (bf16*)(ws + S2);
    float* H = (float*)d_out; bf16* U2 = (bf16*)(ws + S0);

    k_tables<<<1024, 256, 0, stream>>>(ROPE_RET, ROPE_MLA);
    k_mod<<<dim3(6144 / 256, 8), 256, 0, stream>>>(c, w_ada, b_ada, MOD);
    k_normmod<<<M / 4, 256, 0, stream>>>(x, norm1, MOD, 0, 1024, XN);
    auto gemm = [&](const bf16* A, int lda, const float* W, int ldw, const float* kg, int N, int K, Epi e) {
        k_gemm<<<dim3(N / 64, M / 64), 256, 0, stream>>>(A, lda, W, ldw, kg, K, e); };
    Epi e{}; e.mode = 0; e.ldc = 1024;
    e.out = RQ; gemm(XN, 1024, w_in + C_RQ, IN_W, nullptr, 1024, 1024, e);
    e.out = RK; gemm(XN, 1024, w_in + C_RK, IN_W, nullptr, 1024, 1024, e);
    e.out = RV; gemm(XN, 1024, w_in + C_RV, IN_W, nullptr, 1024, 1024, e);
    e.out = CQ; e.ldc = 384; gemm(XN, 1024, w_in + C_CQ, IN_W, nullptr, 384, 1024, e);
    e.out = CKV; e.ldc = 256; gemm(XN, 1024, w_in + C_CKV, IN_W, nullptr, 256, 1024, e);
    e.out = KPE; e.ldc = 64; gemm(XN, 1024, w_in + C_KPE, IN_W, nullptr, 64, 1024, e);
    k_rope<<<(M * 4 * 128) / 256, 256, 0, stream>>>(RQ, 1024, 0, 256, 4, 128, ROPE_RET, 1.f);
    k_rope<<<(M * 4 * 128) / 256, 256, 0, stream>>>(RK, 1024, 0, 256, 4, 128, ROPE_RET, 0.0625f);
    k_rope<<<(M * 32) / 256, 256, 0, stream>>>(KPE, 64, 0, 64, 1, 32, ROPE_MLA, 1.f);
    k_rowscale<<<M / 4, 256, 0, stream>>>(CQ, 384, RSQ);
    k_rowscale<<<M / 4, 256, 0, stream>>>(CKV, 256, RSKV);
    k_attn<256, 256, 1><<<dim3(SEQ / 32, 4, 8), 256, 0, stream>>>(RQ, RK, nullptr, RV, YR);
    e.mode = 1; e.out = RGs; e.ldc = 1024; gemm(XN, 1024, w_in + C_RG, IN_W, nullptr, 1024, 1024, e);
    k_headnorm<<<(M * 4) / 4, 256, 0, stream>>>(YR, RGs);
    e.mode = 3; e.out = Qb; e.ldc = 1536; e.rs = RSQ; gemm(CQ, 384, w_uq, 1536, q_norm, 1536, 384, e);
    e.out = KVB; e.ldc = 2048; e.rs = RSKV; gemm(CKV, 256, w_ukv, 2048, kv_norm, 2048, 256, e);
    k_rope<<<(M * 8 * 32) / 256, 256, 0, stream>>>(Qb, 1536, 128, 192, 8, 32, ROPE_MLA, 1.f);
    k_attn<192, 128, 0><<<dim3(SEQ / 32, 8, 8), 256, 0, stream>>>(Qb, KVB, KPE, KVB, ATT);
    e.mode = 2; e.out = GR; e.ldc = 1024; gemm(XN, 1024, w_in + C_GR, IN_W, nullptr, 1024, 1024, e);
    e.out = GM; gemm(XN, 1024, w_in + C_GM, IN_W, nullptr, 1024, 1024, e);
    e.mode = 4; e.out = GR; gemm(YR, 1024, w_ret_o, 1024, nullptr, 1024, 1024, e);
    e.mode = 5; e.out = GM; e.t1 = GR; gemm(ATT, 1024, w_mla_o, 1024, nullptr, 1024, 1024, e);
    e.mode = 6; e.x = x; e.mod = MOD; e.g_off = 2048; e.outf = H; gemm(GM, 1024, w_out, 1024, nullptr, 1024, 1024, e);
    k_u2route<<<M / 4, 256, 0, stream>>>(H, norm2, MOD, w_grp, b_grp, w_exp, b_exp, U2, ROUTE);
    k_moe_final<<<M, 256, 0, stream>>>(U2, ROUTE, w1, w3, w2, H, MOD, fnorm, out);
}
```

```cpp
#include <hip/hip_runtime.h>
#include <cstdint>
#include <cstdio>

typedef unsigned short bf16;
#define DEV __device__ __forceinline__

constexpr int D_MODEL = 1024, BATCH = 8, SEQ = 2048, M = BATCH * SEQ;
constexpr int RET_HEADS = 4, RET_DK = 256, RET_DV = 256;
constexpr int MLA_HEADS = 8, MLA_NOPE = 128, MLA_ROPE = 64, MLA_V = 128, MLA_Q_LORA = 384, MLA_KV_LORA = 256;
constexpr int N_GROUPS = 4, EPG = 8, D_EXPERT = 256;
constexpr int IN_W = 6848;
constexpr float EPS = 1e-6f;
constexpr int C_RQ = 0, C_RK = 1024, C_RV = 2048, C_RG = 3072, C_CQ = 4096, C_CKV = 4480, C_KPE = 4736, C_GR = 4800, C_GM = 5824;

constexpr size_t MiB = 1u << 20;
constexpr size_t WS_MOD = 1 * MiB;
constexpr size_t WS_RS_Q = 1 * MiB + 512 * 1024;
constexpr size_t WS_RS_KV = 1 * MiB + 640 * 1024;
constexpr size_t WS_ROPE_RET = 2 * MiB;
constexpr size_t WS_ROPE_MLA = 4 * MiB;
constexpr size_t WS_ROUTE = 6 * MiB;
constexpr size_t S0 = 32 * MiB, S1 = 64 * MiB, S2 = 96 * MiB, S3 = 128 * MiB, S4 = 160 * MiB, S5 = 192 * MiB, S6 = 224 * MiB;

DEV float bf2f(bf16 v) { return __uint_as_float((unsigned)v << 16); }
DEV bf16 f2bf(float f) { unsigned u = __float_as_uint(f); return (bf16)((u + 0x7fffu + ((u >> 16) & 1u)) >> 16); }
DEV float silu_f(float v) { return v / (1.f + __expf(-v)); }
DEV float sigmoid_f(float v) { return 1.f / (1.f + __expf(-v)); }
DEV float wave_sum(float v) {
#pragma unroll
    for (int o = 1; o < 64; o <<= 1) v += __shfl_xor(v, o);
    return v;
}

__global__ void k_tables(float* ret_cs, float* mla_cs) {
    int idx = blockIdx.x * blockDim.x + threadIdx.x;
    if (idx < 2048 * 128) {
        int pos = idx / 128, i = idx % 128;
        float inv = (float)pow(10000.0, -(double)(2 * i) / 256.0);
        float ang = (float)pos * inv;
        ret_cs[idx] = (float)cos((double)ang); ret_cs[2048 * 128 + idx] = (float)sin((double)ang);
    }
    if (idx < 2048 * 32) {
        int pos = idx / 32, i = idx % 32;
        float inv = (float)pow(10000.0, -(double)(2 * i) / 64.0);
        float ang = (float)pos * inv;
        mla_cs[idx] = (float)cos((double)ang); mla_cs[2048 * 32 + idx] = (float)sin((double)ang);
    }
}

__global__ void k_mod(const float* c, const float* w_ada, const float* b_ada, float* mod) {
    int n = blockIdx.x * blockDim.x + threadIdx.x, b = blockIdx.y;
    float acc = 0.f;
    for (int k = 0; k < 1024; ++k) acc += silu_f(c[b * 1024 + k]) * w_ada[(size_t)k * 6144 + n];
    mod[b * 6144 + n] = acc + b_ada[n];
}

__global__ void k_normmod(const float* in, const float* gain, const float* mod, int sh_off, int sc_off, bf16* out) {
    int row = blockIdx.x * (blockDim.x / 64) + threadIdx.x / 64, lane = threadIdx.x & 63;
    int b = row / SEQ;
    const float* r = in + (size_t)row * 1024;
    float v[16]; float ss = 0.f;
#pragma unroll
    for (int i = 0; i < 16; ++i) { v[i] = r[lane + 64 * i]; ss += v[i] * v[i]; }
    ss = wave_sum(ss);
    float rs = rsqrtf(ss * (1.f / 1024.f) + EPS);
#pragma unroll
    for (int i = 0; i < 16; ++i) { int col = lane + 64 * i;
        float y = v[i] * rs * gain[col];
        y = y * (1.f + mod[b * 6144 + sc_off + col]) + mod[b * 6144 + sh_off + col];
        out[(size_t)row * 1024 + col] = f2bf(y); }
}

struct Epi {
    int mode;
    bf16* out; int ldc;
    const float* rs;
    const bf16* t1;
    const float* x; const float* mod; int g_off; float* outf;
};
__global__ void __launch_bounds__(256) k_gemm(const bf16* A, int lda, const float* W, int ldw, const float* kgain, int K, Epi e) {
    __shared__ float As[16][65]; __shared__ float Bs[16][64];
    int t = threadIdx.x, tx = t % 16, ty = t / 16;
    int m0 = blockIdx.y * 64, n0 = blockIdx.x * 64;
    float acc[4][4] = {};
    for (int k0 = 0; k0 < K; k0 += 16) {
#pragma unroll
        for (int i = 0; i < 4; ++i) { int idx = t + 256 * i; int r = idx / 16, kk = idx % 16; As[kk][r] = bf2f(A[(size_t)(m0 + r) * lda + k0 + kk]); }
#pragma unroll
        for (int i = 0; i < 4; ++i) { int idx = t + 256 * i; int kk = idx / 64, n = idx % 64; float w = W[(size_t)(k0 + kk) * ldw + n0 + n]; if (kgain) w *= kgain[k0 + kk]; Bs[kk][n] = w; }
        __syncthreads();
#pragma unroll
        for (int kk = 0; kk < 16; ++kk) { float a[4], b[4];
#pragma unroll
            for (int i = 0; i < 4; ++i) { a[i] = As[kk][ty * 4 + i]; b[i] = Bs[kk][tx * 4 + i]; }
#pragma unroll
            for (int i = 0; i < 4; ++i)
#pragma unroll
                for (int j = 0; j < 4; ++j) acc[i][j] += a[i] * b[j]; }
        __syncthreads();
    }
#pragma unroll
    for (int i = 0; i < 4; ++i)
#pragma unroll
        for (int j = 0; j < 4; ++j) { int m = m0 + ty * 4 + i, n = n0 + tx * 4 + j; float v = acc[i][j]; size_t o = (size_t)m * e.ldc + n;
            switch (e.mode) {
                case 0: e.out[o] = f2bf(v); break;
                case 1: e.out[o] = f2bf(silu_f(v)); break;
                case 2: e.out[o] = f2bf(sigmoid_f(v)); break;
                case 3: e.out[o] = f2bf(v * e.rs[m]); break;
                case 4: e.out[o] = f2bf(bf2f(e.out[o]) * v); break;
                case 5: e.out[o] = f2bf(bf2f(e.t1[o]) + bf2f(e.out[o]) * v); break;
                case 6: e.outf[o] = e.x[o] + e.mod[(m / SEQ) * 6144 + e.g_off + n] * v; break;
            } }
}

__global__ void k_rowscale(const bf16* A, int W, float* rs) {
    int row = blockIdx.x * (blockDim.x / 64) + threadIdx.x / 64, lane = threadIdx.x & 63;
    float ss = 0.f;
    for (int c = lane; c < W; c += 64) { float v = bf2f(A[(size_t)row * W + c]); ss += v * v; }
    ss = wave_sum(ss);
    if (lane == 0) rs[row] = rsqrtf(ss / (float)W + EPS);
}

__global__ void k_rope(bf16* buf, int ld, int col0, int hstride, int nheads, int HALF, const float* cs, float scale) {
    size_t idx = (size_t)blockIdx.x * blockDim.x + threadIdx.x;
    size_t total = (size_t)M * nheads * HALF;
    if (idx >= total) return;
    int i = idx % HALF; int h = (idx / HALF) % nheads; int m = idx / ((size_t)HALF * nheads);
    int pos = m % SEQ;
    float c = cs[pos * HALF + i], s = cs[2048 * HALF + pos * HALF + i];
    bf16* p = buf + (size_t)m * ld + col0 + h * hstride;
    float x1 = bf2f(p[i]), x2 = bf2f(p[i + HALF]);
    p[i] = f2bf((x1 * c - x2 * s) * scale); p[i + HALF] = f2bf((x2 * c + x1 * s) * scale);
}

template <int DQK, int DV, int MODE>
__global__ void __launch_bounds__(256) k_attn(const bf16* Q, const bf16* K1, const bf16* K2, const bf16* V, bf16* O) {
    __shared__ bf16 qs[32][DQK + 2]; __shared__ bf16 ks[32][DQK + 2]; __shared__ bf16 vs[32][DV];
    __shared__ float ss[32][33]; __shared__ float m_s[32], l_s[32], al_s[32];
    const int t = threadIdx.x, qt = blockIdx.x, h = blockIdx.y, b = blockIdx.z;
    const size_t row0 = (size_t)b * SEQ + qt * 32;
    constexpr int RPT = (32 * DV) / 256;
    const int col = t % DV, rbase = (t / DV) * RPT;
    float acc[RPT];
#pragma unroll
    for (int i = 0; i < RPT; ++i) acc[i] = 0.f;
    for (int idx = t; idx < 32 * DQK; idx += 256) { int r = idx / DQK, d = idx % DQK;
        qs[r][d] = (MODE == 0) ? Q[(row0 + r) * 1536 + h * 192 + d] : Q[(row0 + r) * 1024 + h * 256 + d]; }
    if (t < 32) { m_s[t] = -INFINITY; l_s[t] = 0.f; }
    const float lg2 = (MODE == 1) ? log2f(1.f - exp2f(-5.f - (float)h)) : 0.f;
    const float scale = (MODE == 0) ? 0.07216878364870322f : 1.f;
    for (int kt = 0; kt <= qt; ++kt) {
        const size_t k0 = (size_t)b * SEQ + kt * 32;
        __syncthreads();
        for (int idx = t; idx < 32 * DQK; idx += 256) { int r = idx / DQK, d = idx % DQK;
            if (MODE == 0) ks[r][d] = (d < 128) ? K1[(k0 + r) * 2048 + h * 256 + d] : K2[(k0 + r) * 64 + d - 128];
            else ks[r][d] = K1[(k0 + r) * 1024 + h * 256 + d]; }
        for (int idx = t; idx < 32 * DV; idx += 256) { int r = idx / DV, d = idx % DV;
            vs[r][d] = (MODE == 0) ? V[(k0 + r) * 2048 + h * 256 + 128 + d] : V[(k0 + r) * 1024 + h * 256 + d]; }
        __syncthreads();
        { const int i = t / 8, j0 = (t % 8) * 4; float s[4] = {0.f, 0.f, 0.f, 0.f};
            for (int d = 0; d < DQK; ++d) { float qv = bf2f(qs[i][d]);
#pragma unroll
                for (int jj = 0; jj < 4; ++jj) s[jj] += qv * bf2f(ks[j0 + jj][d]); }
#pragma unroll
            for (int jj = 0; jj < 4; ++jj) { int ig = qt * 32 + i, jg = kt * 32 + j0 + jj; float v;
                if (MODE == 0) v = (jg <= ig) ? s[jj] * scale : -INFINITY;
                else v = (jg <= ig) ? s[jj] : 0.f;
                ss[i][j0 + jj] = v; } }
        __syncthreads();
        if (MODE == 0) {
            if (t < 32) { float mo = m_s[t], mx = -INFINITY;
                for (int j = 0; j < 32; ++j) mx = fmaxf(mx, ss[t][j]);
                float mn = fmaxf(mo, mx), alpha = __expf(mo - mn), sum = 0.f;
                for (int j = 0; j < 32; ++j) { float p = __expf(ss[t][j] - mn); ss[t][j] = p; sum += p; }
                l_s[t] = l_s[t] * alpha + sum; m_s[t] = mn; al_s[t] = alpha; }
            __syncthreads();
        }
#pragma unroll
        for (int i = 0; i < RPT; ++i) { float a = (MODE == 0) ? acc[i] * al_s[rbase + i] : acc[i];
            for (int j = 0; j < 32; ++j) a += ss[rbase + i][j] * bf2f(vs[j][col]);
            acc[i] = a; }
    }
    __syncthreads();
#pragma unroll
    for (int i = 0; i < RPT; ++i) { float v = (MODE == 0) ? acc[i] / l_s[rbase + i] : acc[i];
        if (MODE == 0) O[(row0 + rbase + i) * 1024 + h * 128 + col] = f2bf(v); else O[(row0 + rbase + i) * 1024 + h * 256 + col] = f2bf(v); }
}

__global__ void k_headnorm(bf16* YR, const bf16* RGs) {
    int w = blockIdx.x * (blockDim.x / 64) + threadIdx.x / 64, lane = threadIdx.x & 63;
    size_t base = (size_t)(w / 4) * 1024 + (w % 4) * 256;
    float v[4], s = 0.f;
#pragma unroll
    for (int i = 0; i < 4; ++i) { v[i] = bf2f(YR[base + lane + 64 * i]); s += v[i]; }
    float mu = wave_sum(s) * (1.f / 256.f), q = 0.f;
#pragma unroll
    for (int i = 0; i < 4; ++i) { v[i] -= mu; q += v[i] * v[i]; }
    float rstd = rsqrtf(wave_sum(q) * (1.f / 256.f) + EPS);
#pragma unroll
    for (int i = 0; i < 4; ++i) YR[base + lane + 64 * i] = f2bf(v[i] * rstd * bf2f(RGs[base + lane + 64 * i]));
}

struct Route { int e0, e1; float w0, w1; };
__global__ void k_u2route(const float* H, const float* gain, const float* mod, const float* w_grp, const float* b_grp, const float* w_exp, const float* b_exp, bf16* U2, Route* route) {
    int row = blockIdx.x * (blockDim.x / 64) + threadIdx.x / 64, lane = threadIdx.x & 63;
    int b = row / SEQ;
    const float* r = H + (size_t)row * 1024;
    float v[16]; float ss = 0.f;
#pragma unroll
    for (int i = 0; i < 16; ++i) { v[i] = r[lane + 64 * i]; ss += v[i] * v[i]; }
    ss = wave_sum(ss);
    float rs = rsqrtf(ss * (1.f / 1024.f) + EPS);
#pragma unroll
    for (int i = 0; i < 16; ++i) { int col = lane + 64 * i;
        float y = v[i] * rs * gain[col];
        y = y * (1.f + mod[b * 6144 + 4096 + col]) + mod[b * 6144 + 3072 + col];
        v[i] = y; U2[(size_t)row * 1024 + col] = f2bf(y); }
    float gl0, gl1, gl2, gl3, mine = 0.f;
    { float a0 = 0.f, a1 = 0.f, a2 = 0.f, a3 = 0.f;
#pragma unroll
        for (int i = 0; i < 16; ++i) { const float* wg = w_grp + (lane + 64 * i) * 4; a0 += v[i] * wg[0]; a1 += v[i] * wg[1]; a2 += v[i] * wg[2]; a3 += v[i] * wg[3]; }
        gl0 = wave_sum(a0) + b_grp[0]; gl1 = wave_sum(a1) + b_grp[1]; gl2 = wave_sum(a2) + b_grp[2]; gl3 = wave_sum(a3) + b_grp[3]; }
    for (int e = 0; e < 32; ++e) { float a = 0.f;
#pragma unroll
        for (int i = 0; i < 16; ++i) a += v[i] * w_exp[(lane + 64 * i) * 32 + e];
        a = wave_sum(a) + b_exp[e]; if (lane == e) mine = a; }
    {
        int gs = 0; float gm = gl0;
        if (gl1 > gm) { gm = gl1; gs = 1; } if (gl2 > gm) { gm = gl2; gs = 2; } if (gl3 > gm) { gm = gl3; gs = 3; }
        float den = __expf(gl0 - gm) + __expf(gl1 - gm) + __expf(gl2 - gm) + __expf(gl3 - gm);
        float pg = 1.f / den;
        int i0 = 0; float v0 = -INFINITY;
#pragma unroll
        for (int e = 0; e < 8; ++e) { float xv = __shfl(mine, gs * 8 + e); if (xv > v0) { v0 = xv; i0 = e; } }
        int i1 = 0; float v1 = -INFINITY;
#pragma unroll
        for (int e = 0; e < 8; ++e) { float xv = __shfl(mine, gs * 8 + e); if (e != i0 && xv > v1) { v1 = xv; i1 = e; } }
        float e1 = __expf(v1 - v0), inv = 1.f / (1.f + e1);
        if (lane == 0) { Route rt; rt.e0 = gs * 8 + i0; rt.e1 = gs * 8 + i1; rt.w0 = inv * pg; rt.w1 = e1 * inv * pg; route[row] = rt; }
    }
}

__global__ void __launch_bounds__(256) k_moe_final(const bf16* U2, const Route* route, const float* w1, const float* w3, const float* w2, const float* H, const float* mod, const float* fnorm, float* out) {
    __shared__ float us[1024]; __shared__ float hid[256]; __shared__ float red[4];
    int row = blockIdx.x, t = threadIdx.x, b = row / SEQ;
    for (int i = t; i < 1024; i += 256) us[i] = bf2f(U2[(size_t)row * 1024 + i]);
    Route rt = route[row];
    float o[4] = {0.f, 0.f, 0.f, 0.f};
    for (int k = 0; k < 2; ++k) {
        int e = k ? rt.e1 : rt.e0; float gw = k ? rt.w1 : rt.w0;
        const float* W1 = w1 + (size_t)e * 1024 * 256; const float* W3 = w3 + (size_t)e * 1024 * 256; const float* W2 = w2 + (size_t)e * 256 * 1024;
        __syncthreads();
        float a = 0.f, c = 0.f;
        for (int d = 0; d < 1024; ++d) { float u = us[d]; a += u * W1[(size_t)d * 256 + t]; c += u * W3[(size_t)d * 256 + t]; }
        hid[t] = bf2f(f2bf(silu_f(a) * c * gw));
        __syncthreads();
        for (int f = 0; f < 256; ++f) { float hv = hid[f];
#pragma unroll
            for (int i = 0; i < 4; ++i) o[i] += hv * W2[(size_t)f * 1024 + t + 256 * i]; }
    }
    float hv[4], ss = 0.f;
#pragma unroll
    for (int i = 0; i < 4; ++i) { int col = t + 256 * i; hv[i] = H[(size_t)row * 1024 + col] + mod[b * 6144 + 5120 + col] * o[i]; ss += hv[i] * hv[i]; }
    ss = wave_sum(ss);
    __syncthreads();
    if ((t & 63) == 0) red[t / 64] = ss;
    __syncthreads();
    float tot = red[0] + red[1] + red[2] + red[3];
    float rs = rsqrtf(tot * (1.f / 1024.f) + EPS);
#pragma unroll
    for (int i = 0; i < 4; ++i) { int col = t + 256 * i; out[(size_t)row * 1024 + col] = hv[i] * rs * fnorm[col]; }
}

#define LAS __attribute__((address_space(3)))
#define GAS __attribute__((address_space(1)))
typedef short bf16x8 __attribute__((ext_vector_type(8)));
typedef float f32x4 __attribute__((ext_vector_type(4)));
typedef float f32x2 __attribute__((ext_vector_type(2)));
typedef unsigned u32x4 __attribute__((ext_vector_type(4)));
typedef unsigned u32x2 __attribute__((ext_vector_type(2)));
#define LDS_WAIT() asm volatile("s_waitcnt lgkmcnt(0)" ::: "memory")
#define VM_WAIT() asm volatile("s_waitcnt vmcnt(0)" ::: "memory")

constexpr int NWAVES = 8;
constexpr int RING_BYTES = 131072, LDSCTL_OFF = RING_BYTES, MISC_OFF = LDSCTL_OFF + 320, EX_OFF = RING_BYTES + 1024, LDS_BYTES = 147456;

constexpr size_t WS_CTL = 0, CTL_ZERO_BYTES = 1 * MiB;
constexpr int CW_BAR = 4096;
constexpr size_t WS_WIN = 8 * MiB, WS_WRG = 16 * MiB, WS_WGR = 18 * MiB, WS_WRETO = 20 * MiB, WS_WGM = 22 * MiB, WS_WMLAO = 24 * MiB, WS_WOUT = 26 * MiB, WS_WUQ = 28 * MiB, WS_WUKV = 30 * MiB;
constexpr size_t WS_MODP = S6;

DEV int lane_id() { int r; asm volatile("v_mbcnt_lo_u32_b32 %0, -1, 0\n\tv_mbcnt_hi_u32_b32 %0, -1, %0" : "=v"(r)); return r; }
DEV unsigned cvt_pk_bf16(float lo, float hi) { unsigned r; asm volatile("v_cvt_pk_bf16_f32 %0, %1, %2" : "=v"(r) : "v"(lo), "v"(hi)); return r; }
DEV unsigned pk2(float lo, float hi) { return (unsigned)f2bf(lo) | ((unsigned)f2bf(hi) << 16); }

#define XB_TMO      128
#define XB_XCNT(j)  (256  + 64 * (j))
#define XB_XSUB(j)  (1280 + 64 * (j))
#define XB_XGEN(j)  (2304 + 64 * (j))
#define XB_TOP      3328
#define XB_TOPGEN   3392
#define XCD_BAR_WORDS 3456
#define XB_SPIN_CAP (1u << 18)
DEV unsigned xb_ld(unsigned* p)              { return __hip_atomic_load(p, __ATOMIC_RELAXED, __HIP_MEMORY_SCOPE_AGENT); }
DEV unsigned xb_add(unsigned* p, unsigned v) { return __hip_atomic_fetch_add(p, v, __ATOMIC_RELAXED, __HIP_MEMORY_SCOPE_AGENT); }
DEV unsigned xb_xcc_id() { return (unsigned)__builtin_amdgcn_s_getreg((3 << 11) | 20) & 0xFu; }
#define XB_SPIN(cond, bar) do { unsigned _sp = 0; while (cond) { __builtin_amdgcn_s_sleep(1); \
    if ((++_sp & 255u) == 0u) { if (xb_ld(&(bar)[XB_TMO])) break; if (_sp > XB_SPIN_CAP) { atomicAdd(&(bar)[XB_TMO], 1u); break; } } } } while (0)
struct XcdBarrier { unsigned* bar; unsigned x; volatile LAS unsigned* st; };
DEV XcdBarrier xcd_barrier_post(unsigned* bar, volatile LAS unsigned* st) {
    XcdBarrier b; b.bar = bar; b.x = xb_xcc_id(); b.st = st;
    if (threadIdx.x == 0) (void)xb_add(&bar[XB_XCNT(b.x)], 1u);
    return b;
}
DEV void xcd_barrier_complete(unsigned* bar, unsigned x, unsigned& nloc, unsigned& nx) {
    const unsigned G = gridDim.x * gridDim.y * gridDim.z;
    unsigned sum, cnt, mine, sp = 0u;
    for (;;) {
        sum = 0u; cnt = 0u; mine = 0u;
#pragma unroll
        for (unsigned j = 0; j < 16; ++j) { const unsigned c = xb_ld(&bar[XB_XCNT(j)]); sum += c; cnt += (c > 0u) ? 1u : 0u; mine = (j == x) ? c : mine; }
        if (sum == G) break;
        __builtin_amdgcn_s_sleep(1);
        if ((++sp & 255u) == 0u) { if (xb_ld(&bar[XB_TMO])) break; if (sp > XB_SPIN_CAP) { atomicAdd(&bar[XB_TMO], 1u); break; } }
    }
    nloc = mine > 0u ? mine : 1u; nx = cnt > 0u ? cnt : 1u;
}
DEV void xcd_barrier(const XcdBarrier& b) {
    asm volatile("s_waitcnt vmcnt(0)" ::: "memory");
    __syncthreads();
    if (threadIdx.x == 0) {
        unsigned* bar = b.bar;
        __builtin_amdgcn_s_waitcnt(0);
        unsigned nloc = b.st[0], nx = b.st[1];
        if (nloc == 0u) { xcd_barrier_complete(bar, b.x, nloc, nx); b.st[0] = nloc; b.st[1] = nx; }
        const unsigned old = xb_add(&bar[XB_XSUB(b.x)], 1u);
        const unsigned gen = old / nloc;
        if (old + 1u == (gen + 1u) * nloc) {
            __builtin_amdgcn_fence(__ATOMIC_RELEASE, "agent");
            asm volatile("s_waitcnt vmcnt(0)" ::: "memory");
            const unsigned og = xb_add(&bar[XB_TOP], 1u);
            const unsigned tg = og / nx;
            if (og + 1u == (tg + 1u) * nx) xb_add(&bar[XB_TOPGEN], 1u);
            else XB_SPIN(xb_ld(&bar[XB_TOPGEN]) == tg, bar);
            __builtin_amdgcn_fence(__ATOMIC_ACQUIRE, "agent");
            xb_add(&bar[XB_XGEN(b.x)], 1u);
            asm volatile("s_waitcnt vmcnt(0)" ::: "memory");
        } else {
            XB_SPIN(xb_ld(&bar[XB_XGEN(b.x)]) == gen, bar);
            __builtin_amdgcn_fence(__ATOMIC_ACQUIRE, "agent");
            asm volatile("s_waitcnt vmcnt(0)" ::: "memory");
        }
    }
    __syncthreads();
}

namespace pg8 {
constexpr int BM = 256, BK = 64, HALF = 128, HTB = HALF * BK * 2, STAGE_BYTES = 8 * HTB, NXCD = 8, WGM = 8;
DEV int lds_byte(int r, int c) { const int st = (r >> 4) * 2 + (c >> 5), rr = r & 15, cc = c & 31, ob = rr * 64 + cc * 2; return st * 1024 + (ob ^ (((ob >> 9) & 1) << 5)); }
DEV void stage_rc(int b, int& R, int& C) { const int st = b / 1024, sb = b % 1024, swz = sb ^ (((sb >> 9) & 1) << 5); R = (st >> 1) * 16 + swz / 64; C = (st & 1) * 32 + (swz % 64) / 2; }
DEV int perm32(int rho) { const int n = rho >> 4, i = rho & 15; return 8 * (i >> 2) + 4 * n + (i & 3); }

struct Unit { const char* A; const char* B; int pm, pn, kind; const int* tok; };

DEV bool static_tile(int i, int G, int c, int nM, int nN, int& pm, int& pn) {
    const int nwg = nM * nN; const long L = (long)i * G + c; if (L >= nwg) return false;
    int wgid = (int)L; { const int q = nwg / NXCD, r = nwg % NXCD, xcd = wgid % NXCD, off = wgid / NXCD; wgid = (xcd < r ? xcd * (q + 1) : r * (q + 1) + (xcd - r) * q) + off; }
    const int nig = WGM * nN, gid = wgid / nig, fm = gid * WGM, gsz = (nM - fm) < WGM ? (nM - fm) : WGM;
    pm = fm + ((wgid % nig) % gsz); pn = (wgid % nig) / gsz; return true;
}

template <class Epi, class Sched, bool GATHER = false>
DEV void gemm_phase(LAS unsigned char* lds, const int wave_id, const int K, const Sched& S, const Epi& E) {
    const int lane_ = lane_id();
    const int wid = wave_id, lane = lane_, tid = wid * 64 + lane, wr = wid >> 2, wc = wid & 3, fr = lane & 15, fq = lane >> 4;
    const int nt = K / BK;
    unsigned voffA[2], voffB[2];
#pragma unroll
    for (int i = 0; i < 2; ++i) { int R, C; stage_rc(tid * 16 + i * 8192, R, C); const int Rb = Epi::PERM ? ((R & ~31) + perm32(R & 31)) : R;
        voffA[i] = (unsigned)(R * K + C) * 2u; voffB[i] = (unsigned)(Rb * K + C) * 2u; }
    const size_t kstep = (size_t)(BK * 2);
    const size_t hstep = (size_t)HALF * K * 2;
    const unsigned ldsw = (unsigned)wid * 1024u;
    const int aoff = lds_byte(wr * 64 + fr, fq * 8), boff = lds_byte(wc * 32 + fr, fq * 8);
#define PG8_SA(b, h) (((b) * 2 + (h)) * HTB)
#define PG8_SB(b, h) ((4 + (b) * 2 + (h)) * HTB)
#define PG8_STAGE(bufoff, gbase, voff) do { _Pragma("unroll") for (int _i = 0; _i < 2; ++_i) \
        __builtin_amdgcn_global_load_lds((const unsigned*)((const char*)(gbase) + (voff)[_i]), (LAS unsigned*)(lds + (bufoff) + ldsw + _i * 8192), 16, 0, 0); } while (0)
#define PG8_LDA(dst, b, h) do { _Pragma("unroll") for (int m = 0; m < 4; ++m) _Pragma("unroll") for (int k = 0; k < 2; ++k) dst[m][k] = *(const LAS bf16x8*)(lds + PG8_SA(b, h) + aoff + m * 2048 + k * 1024); } while (0)
#define PG8_LDB(dst, b, h) do { _Pragma("unroll") for (int n = 0; n < 2; ++n) _Pragma("unroll") for (int k = 0; k < 2; ++k) dst[n][k] = *(const LAS bf16x8*)(lds + PG8_SB(b, h) + boff + n * 2048 + k * 1024); } while (0)
#define PG8_MMA(ai, bj, At, Bt) do { __builtin_amdgcn_s_setprio(1); _Pragma("unroll") for (int m = 0; m < 4; ++m) _Pragma("unroll") for (int n = 0; n < 2; ++n) _Pragma("unroll") for (int k = 0; k < 2; ++k) \
        acc[ai][bj][m][n] = __builtin_amdgcn_mfma_f32_16x16x32_bf16(Bt[n][k], At[m][k], acc[ai][bj][m][n], 0, 0, 0); __builtin_amdgcn_s_setprio(0); } while (0)
#define PG8_WAIT_V(n) asm volatile("s_waitcnt vmcnt(" #n ")" ::: "memory")
#define PG8_WAIT_L(n) asm volatile("s_waitcnt lgkmcnt(" #n ")" ::: "memory")
#define PG8_BAR __builtin_amdgcn_s_barrier()
#define PG8_SCHED __builtin_amdgcn_sched_barrier(0)
    Unit cur, nxt; int ui = 0;
    if (!S.next(0, cur)) return;
    f32x4 acc[2][2][4][2];
#pragma unroll
    for (int a = 0; a < 2; ++a)
#pragma unroll
        for (int b = 0; b < 2; ++b)
#pragma unroll
            for (int m = 0; m < 4; ++m)
#pragma unroll
                for (int n = 0; n < 2; ++n) acc[a][b][m][n] = (f32x4){0.f, 0.f, 0.f, 0.f};
    bf16x8 At[4][2], B0[2][2], B1[2][2];
    const char* cA = cur.A; const char* cB = cur.B;
    unsigned vg[2][2], nvg[2][2];
#define PG8_GLOAD(dst, u) do { if constexpr (GATHER) { _Pragma("unroll") for (int h_ = 0; h_ < 2; ++h_) _Pragma("unroll") for (int i_ = 0; i_ < 2; ++i_) { int R_, C_; stage_rc(tid * 16 + i_ * 8192, R_, C_); \
        dst[h_][i_] = (unsigned)(u).tok[h_ * 128 + R_] * (unsigned)(K * 2) + (unsigned)(C_ * 2); } } } while (0)
#define PG8_STAGE_A(bufoff, ptr, H, NX) do { if constexpr (GATHER) { if (NX) PG8_STAGE(bufoff, ptr, nvg[H]); else PG8_STAGE(bufoff, ptr, vg[H]); } else PG8_STAGE(bufoff, (ptr) + (H) * hstep, voffA); } while (0)
    PG8_GLOAD(vg, cur);
    PG8_STAGE(PG8_SB(0, 0), cB, voffB); PG8_STAGE(PG8_SB(0, 1), cB + hstep, voffB); PG8_STAGE_A(PG8_SA(0, 0), cA, 0, false); PG8_STAGE_A(PG8_SA(0, 1), cA, 1, false);
    if (wr == 1) PG8_BAR;
    PG8_WAIT_V(2); PG8_BAR;
    PG8_STAGE(PG8_SB(1, 0), cB + kstep, voffB); PG8_STAGE_A(PG8_SA(1, 0), cA + kstep, 0, false); PG8_STAGE(PG8_SB(1, 1), cB + hstep + kstep, voffB);
    PG8_WAIT_V(6); PG8_BAR;
    for (;;) {
        const bool has_next = S.next(ui + 1, nxt);
        const char* nA = has_next ? nxt.A : cA; const char* nB = has_next ? nxt.B : cB;
        if constexpr (GATHER) { if (has_next) PG8_GLOAD(nvg, nxt); else { _Pragma("unroll") for (int h_ = 0; h_ < 2; ++h_) _Pragma("unroll") for (int i_ = 0; i_ < 2; ++i_) nvg[h_][i_] = vg[h_][i_]; } }
        for (int t = 0; t < nt; t += 2) {
            const bool last = (t == nt - 2);
            const char* a1 = cA + (size_t)(t + 1) * kstep;
            const char* a2 = last ? nA : cA + (size_t)(t + 2) * kstep; const char* b2 = last ? nB : cB + (size_t)(t + 2) * kstep;
            const char* a3 = a2 + kstep; const char* b3 = b2 + kstep;
            PG8_LDB(B0, 0, 0); PG8_LDB(B1, 0, 1); PG8_SCHED; PG8_LDA(At, 0, 0); PG8_STAGE_A(PG8_SA(1, 1), a1, 1, false);
            PG8_WAIT_V(8); PG8_WAIT_L(0); PG8_BAR; PG8_MMA(0, 0, At, B0); PG8_MMA(0, 1, At, B1); PG8_BAR; PG8_SCHED;
            PG8_LDA(At, 0, 1); PG8_STAGE(PG8_SB(0, 0), b2, voffB); PG8_STAGE(PG8_SB(0, 1), b2 + hstep, voffB); PG8_STAGE_A(PG8_SA(0, 0), a2, 0, last);
            PG8_WAIT_V(8); PG8_WAIT_L(0); PG8_BAR; PG8_MMA(1, 0, At, B0); PG8_MMA(1, 1, At, B1); PG8_BAR; PG8_SCHED;
            PG8_LDB(B0, 1, 0); PG8_LDB(B1, 1, 1); PG8_SCHED; PG8_LDA(At, 1, 0); PG8_STAGE_A(PG8_SA(0, 1), a2, 1, last);
            PG8_WAIT_V(8); PG8_WAIT_L(0); PG8_BAR; PG8_MMA(0, 0, At, B0); PG8_MMA(0, 1, At, B1); PG8_BAR; PG8_SCHED;
            PG8_LDA(At, 1, 1); PG8_STAGE(PG8_SB(1, 0), b3, voffB); PG8_STAGE(PG8_SB(1, 1), b3 + hstep, voffB); PG8_STAGE_A(PG8_SA(1, 0), a3, 0, last);
            PG8_WAIT_V(8); PG8_WAIT_L(0); PG8_BAR; PG8_MMA(1, 0, At, B0); PG8_MMA(1, 1, At, B1); PG8_BAR; PG8_SCHED;
        }
        if (wr == 0) PG8_BAR;
        E(acc, cur, wr, wc, fr, fq);
        if (!has_next) break;
#pragma unroll
        for (int a = 0; a < 2; ++a)
#pragma unroll
            for (int b = 0; b < 2; ++b)
#pragma unroll
                for (int m = 0; m < 4; ++m)
#pragma unroll
                    for (int n = 0; n < 2; ++n) acc[a][b][m][n] = (f32x4){0.f, 0.f, 0.f, 0.f};
        cur = nxt; cA = nA; cB = nB; ++ui;
        if constexpr (GATHER) { _Pragma("unroll") for (int h_ = 0; h_ < 2; ++h_) _Pragma("unroll") for (int i_ = 0; i_ < 2; ++i_) vg[h_][i_] = nvg[h_][i_]; }
        if (wr == 1) PG8_BAR;
    }
    PG8_WAIT_V(0);
    PG8_BAR;
#undef PG8_SA
#undef PG8_SB
#undef PG8_STAGE
#undef PG8_STAGE_A
#undef PG8_GLOAD
#undef PG8_LDA
#undef PG8_LDB
#undef PG8_MMA
#undef PG8_WAIT_V
#undef PG8_WAIT_L
#undef PG8_BAR
#undef PG8_SCHED
}
}
namespace mla {
typedef short s16x4 __attribute__((ext_vector_type(4)));
typedef float f32x16 __attribute__((ext_vector_type(16)));
constexpr int KVBLK = 64, QBLK = 32, QB = 256;
constexpr int SHM_KN = 16384, SHM_KP = 8192, SHM_V = 16384, BUF = SHM_KN + SHM_KP + SHM_V;
constexpr int OFF_KN = 0, OFF_KP = SHM_KN, OFF_V = SHM_KN + SHM_KP, OFF_WS = 2 * BUF;
constexpr float SCALE = 0.07216878364870322f;
constexpr float THR = 8.f;
#define KSWZ(row, colB) ((row) * 256 + ((colB) ^ (((row) & 7) << 4)))
#define KPSWZ(row, colB) ((row) * 128 + ((colB) ^ (((row) & 7) << 4)))
#define SBAR() __builtin_amdgcn_sched_barrier(0)
DEV int v_st(int k, int c) { const int kk = (k & ~0xC) | ((k & 4) << 1) | ((k & 8) >> 1); return ((kk >> 3) * 4 + (c >> 5)) * 512 + ((kk & 7) * 32 + (c & 31)) * 2; }
DEV int v_rd_base(int lane) { return ((lane & 3) << 3) | (((lane >> 2) & 3) << 6) | (((lane >> 4) & 1) << 5) | (((lane >> 5) & 1) << 8); }
constexpr int v_rd_off(int d0, int ks, int half) { return d0 * 512 + ks * 4096 + half * 2048; }
DEV int crow(int r, int hi) { return (r & 3) + 8 * (r >> 2) + 4 * hi; }
DEV void mask_tile(f32x16& p0, f32x16& p1, int dq) {
    const float NEG = -__builtin_inff();
#pragma unroll
    for (int r = 0; r < 16; ++r) { const int c = (r & 3) + 8 * (r >> 2);
        if (dq - c < 0) p0[r] = NEG;
        if (dq - c - 32 < 0) p1[r] = NEG; }
}
DEV void partialSM(f32x16& p0, f32x16& p1, float& m_reg, float& mn, float& alpha) {
    float pmax = p0[0];
#pragma unroll
    for (int r = 1; r < 16; ++r) pmax = fmaxf(pmax, p0[r]);
#pragma unroll
    for (int r = 0; r < 16; ++r) pmax = fmaxf(pmax, p1[r]);
    { auto rr = __builtin_amdgcn_permlane32_swap(__float_as_uint(pmax), __float_as_uint(pmax), false, false);
      pmax = fmaxf(__uint_as_float(rr[0]), __uint_as_float(rr[1])); }
    constexpr float C2 = 1.4426950408889634f * SCALE;
    if (__builtin_expect(__all((pmax - m_reg) * SCALE <= THR), 1)) { mn = m_reg; alpha = 1.f; }
    else { mn = fmaxf(m_reg, pmax); alpha = __builtin_amdgcn_exp2f((m_reg - mn) * C2); m_reg = mn; }
    const float mnL = -mn * C2;
#pragma unroll
    for (int r = 0; r < 16; ++r) p0[r] = fmaf(p0[r], C2, mnL);
#pragma unroll
    for (int r = 0; r < 16; ++r) p1[r] = fmaf(p1[r], C2, mnL);
#pragma unroll
    for (int r = 0; r < 16; ++r) p0[r] = __builtin_amdgcn_exp2f(p0[r]);
}
DEV void finishSM(f32x16& p0, f32x16& p1, float alpha, float& l_reg, bf16x8& pa0, bf16x8& pa1, bf16x8& pa2, bf16x8& pa3) {
#pragma unroll
    for (int r = 0; r < 16; ++r) p1[r] = __builtin_amdgcn_exp2f(p1[r]);
    float ps = 0;
#pragma unroll
    for (int r = 0; r < 16; ++r) ps += p0[r];
#pragma unroll
    for (int r = 0; r < 16; ++r) ps += p1[r];
    { auto rr = __builtin_amdgcn_permlane32_swap(__float_as_uint(ps), __float_as_uint(ps), false, false);
      ps = __uint_as_float(rr[0]) + __uint_as_float(rr[1]); }
    l_reg = l_reg * alpha + ps;
#define PK4(P, B_, OUT) do { unsigned a0 = cvt_pk_bf16(P[B_+0], P[B_+1]), a1 = cvt_pk_bf16(P[B_+2], P[B_+3]);                          \
        unsigned b0 = cvt_pk_bf16(P[B_+4], P[B_+5]), b1 = cvt_pk_bf16(P[B_+6], P[B_+7]);                                             \
        auto r0 = __builtin_amdgcn_permlane32_swap(a0, b0, false, false); auto r1 = __builtin_amdgcn_permlane32_swap(a1, b1, false, false); \
        u32x4 w = {r0[0], r1[0], r0[1], r1[1]}; OUT = __builtin_bit_cast(bf16x8, w); } while (0)
    PK4(p0, 0, pa0); PK4(p0, 8, pa1); PK4(p1, 0, pa2); PK4(p1, 8, pa3);
#undef PK4
}
DEV void qkt(f32x16& p0, f32x16& p1, const LAS char* buf, int r32, int hi, const bf16x8* qr) {
    p0 = f32x16{}; p1 = f32x16{};
    const LAS char* kb[4];
#pragma unroll
    for (int dd = 0; dd < 4; ++dd) kb[dd] = buf + OFF_KN + KSWZ(r32, (dd * 16 + hi * 8) * 2);
#pragma unroll
    for (int d0 = 0; d0 < 8; ++d0) { const LAS char* a = kb[d0 & 3] + (d0 >> 2) * 128;
        const bf16x8 b0 = *(const LAS bf16x8*)a, b1 = *(const LAS bf16x8*)(a + 32 * 256);
        p0 = __builtin_amdgcn_mfma_f32_32x32x16_bf16(b0, qr[d0], p0, 0, 0, 0);
        p1 = __builtin_amdgcn_mfma_f32_32x32x16_bf16(b1, qr[d0], p1, 0, 0, 0); }
#pragma unroll
    for (int d0 = 0; d0 < 4; ++d0) { const LAS char* a = buf + OFF_KP + KPSWZ(r32, (d0 * 16 + hi * 8) * 2);
        const bf16x8 b0 = *(const LAS bf16x8*)a, b1 = *(const LAS bf16x8*)(a + 32 * 128);
        p0 = __builtin_amdgcn_mfma_f32_32x32x16_bf16(b0, qr[8 + d0], p0, 0, 0, 0);
        p1 = __builtin_amdgcn_mfma_f32_32x32x16_bf16(b1, qr[8 + d0], p1, 0, 0, 0); }
}
DEV void pv_tile(f32x16* o, int vb0, bf16x8 pa0, bf16x8 pa1, bf16x8 pa2, bf16x8 pa3) {
#define TRRD(dst, off) asm volatile("ds_read_b64_tr_b16 %0, %1 offset:%2" : "=&v"(dst) : "v"(vb0), "i"(off) : "memory")
#define PV_D0(d0) do { s16x4 l0, l1, l2, l3, h0, h1, h2, h3; constexpr int b_ = v_rd_off(d0, 0, 0); \
        TRRD(l0, b_); TRRD(h0, b_ + 2048); TRRD(l1, b_ + 4096); TRRD(h1, b_ + 6144); TRRD(l2, b_ + 8192); TRRD(h2, b_ + 10240); TRRD(l3, b_ + 12288); TRRD(h3, b_ + 14336); \
        asm volatile("s_waitcnt lgkmcnt(0)" ::: "memory"); SBAR(); \
        o[d0] = __builtin_amdgcn_mfma_f32_32x32x16_bf16(pa0, (bf16x8){l0[0], l0[1], l0[2], l0[3], h0[0], h0[1], h0[2], h0[3]}, o[d0], 0, 0, 0);   \
        o[d0] = __builtin_amdgcn_mfma_f32_32x32x16_bf16(pa1, (bf16x8){l1[0], l1[1], l1[2], l1[3], h1[0], h1[1], h1[2], h1[3]}, o[d0], 0, 0, 0);   \
        o[d0] = __builtin_amdgcn_mfma_f32_32x32x16_bf16(pa2, (bf16x8){l2[0], l2[1], l2[2], l2[3], h2[0], h2[1], h2[2], h2[3]}, o[d0], 0, 0, 0);   \
        o[d0] = __builtin_amdgcn_mfma_f32_32x32x16_bf16(pa3, (bf16x8){l3[0], l3[1], l3[2], l3[3], h3[0], h3[1], h3[2], h3[3]}, o[d0], 0, 0, 0); } while (0)
    PV_D0(0); PV_D0(1); PV_D0(2); PV_D0(3);
#undef PV_D0
#undef TRRD
}
DEV void attn_unit(int b, int h, int q0, const bf16* Q, const bf16* KV, const bf16* KPE, bf16* O, LAS char* lds, int wid) {
    const int lane = lane_id(), tid = wid * 64 + lane, r32 = lane & 31, hi = lane >> 5;
    const size_t rowb = (size_t)b * SEQ;
    const int sr = tid >> 4, sc = (tid & 15) * 8, kws = KSWZ(sr, sc * 2), vst0 = v_st(sr, sc), vst1 = v_st(32 + sr, sc), pr = tid >> 3, pc = (tid & 7) * 8, pws = KPSWZ(pr, pc * 2);
    const bf16* Kg = KV + rowb * 2048 + h * 256 + sc; const bf16* Pg = KPE + rowb * 64 + pc;
    bf16x8 st_k0, st_k1, st_v0, st_v1, st_p;
#define SLOAD(k0) do { st_k0 = *(const bf16x8*)(Kg + (size_t)((k0) + sr) * 2048); st_k1 = *(const bf16x8*)(Kg + (size_t)((k0) + 32 + sr) * 2048); \
        st_v0 = *(const bf16x8*)(Kg + (size_t)((k0) + sr) * 2048 + 128); st_v1 = *(const bf16x8*)(Kg + (size_t)((k0) + 32 + sr) * 2048 + 128); \
        st_p = *(const bf16x8*)(Pg + (size_t)((k0) + pr) * 64); } while (0)
#define SWRITE(bufp) do { *(LAS bf16x8*)((bufp) + OFF_KN + kws) = st_k0; *(LAS bf16x8*)((bufp) + OFF_KN + kws + 32 * 256) = st_k1; \
        *(LAS bf16x8*)((bufp) + OFF_V + vst0) = st_v0; *(LAS bf16x8*)((bufp) + OFF_V + vst1) = st_v1; *(LAS bf16x8*)((bufp) + OFF_KP + pws) = st_p; } while (0)
    SLOAD(0);
    bf16x8 qr[12];
    { const bf16* qp = Q + (rowb + q0 + wid * QBLK + r32) * 1536 + h * 192 + hi * 8;
#pragma unroll
      for (int d0 = 0; d0 < 12; ++d0) qr[d0] = *(const bf16x8*)(qp + d0 * 16); }
    LAS float* wsf = (LAS float*)(lds + OFF_WS) + wid * 64;
    float m_reg = -1e30f, l_reg = 0.f; f32x16 o[4] = {};
    const int NT = (q0 + QB) / KVBLK;
    const int qlo = q0 + wid * QBLK, qm = qlo + r32 - 4 * hi;
    const int vbase = (int)(uintptr_t)(lds + OFF_V) + v_rd_base(lane);
    asm volatile("s_waitcnt vmcnt(12)" ::: "memory");
    SWRITE(lds);
    for (int t = 0; t < NT; ++t) {
        const LAS char* buf = lds + (t & 1) * BUF;
        __syncthreads();
        if (t + 1 < NT) SLOAD((t + 1) * KVBLK);
        f32x16 p0, p1; float mn, alpha; bf16x8 pa0, pa1, pa2, pa3;
        qkt(p0, p1, buf, r32, hi, qr);
        if (t * KVBLK + KVBLK - 1 > qlo) mask_tile(p0, p1, qm - t * KVBLK);
        partialSM(p0, p1, m_reg, mn, alpha);
        finishSM(p0, p1, alpha, l_reg, pa0, pa1, pa2, pa3);
        if (__any(alpha < 1.f)) { if (hi == 0) wsf[r32] = alpha; asm volatile("s_waitcnt lgkmcnt(0)" ::: "memory");
#pragma unroll
            for (int d_ = 0; d_ < 4; ++d_)
#pragma unroll
                for (int r = 0; r < 16; ++r) o[d_][r] *= wsf[crow(r, hi)]; }
        SBAR();
        pv_tile(o, vbase + (t & 1) * BUF, pa0, pa1, pa2, pa3);
        if (t + 1 < NT) { asm volatile("s_waitcnt vmcnt(0)" ::: "memory"); SWRITE(lds + ((t + 1) & 1) * BUF); }
    }
    if (hi == 0) wsf[32 + r32] = l_reg; asm volatile("s_waitcnt lgkmcnt(0)" ::: "memory");
    bf16* Ow = O + (rowb + q0 + wid * QBLK) * 1024 + h * 128;
#pragma unroll
    for (int r = 0; r < 16; ++r) { const int orow = crow(r, hi); const float rl = __builtin_amdgcn_rcpf(wsf[32 + orow]);
#pragma unroll
        for (int d0 = 0; d0 < 4; ++d0) { const float v = o[d0][r] * rl; const float vn = __shfl_xor(v, 1);
            if ((r32 & 1) == 0) *(unsigned*)(Ow + (size_t)orow * 1024 + d0 * 32 + r32) = cvt_pk_bf16(v, vn); } }
    __syncthreads();
#undef SLOAD
#undef SWRITE
}
#undef KSWZ
#undef KPSWZ
#undef SBAR
}
namespace ret {
using mla::f32x16; using mla::s16x4; using mla::v_st; using mla::v_rd_base; using mla::v_rd_off; using mla::crow;
constexpr int RBUF = 49152;
constexpr size_t SB_STRIDE = 256 * 256;
#define KSWZ(row, colB) ((row) * 256 + ((colB) ^ (((row) & 7) << 4)))
#define SBAR() __builtin_amdgcn_sched_barrier(0)
#define TRRDV(dst, base, off) asm volatile("ds_read_b64_tr_b16 %0, %1 offset:%2" : "=&v"(dst) : "v"(base), "i"(off) : "memory")
#define FR8(l, h) (bf16x8){l[0], l[1], l[2], l[3], h[0], h[1], h[2], h[3]}

DEV void scan_unit(int b, int h, int q, const bf16* RK, const bf16* RV, bf16* SBUF, LAS char* lds, int wid) {
    const int lane = lane_id(), tid = wid * 64 + lane, r32 = lane & 31, hi = lane >> 5;
    const size_t rowb = (size_t)b * SEQ;
    const int sr = tid >> 4, sc = (tid & 15) * 8, vr = tid >> 3, vc = (tid & 7) * 8;
    const int ks0 = v_st(sr, sc), ks1 = v_st(32 + sr, sc), vs0 = v_st(vr, vc);
    const bf16* Kg = RK + rowb * 1024 + h * 256 + sc; const bf16* Vg = RV + rowb * 1024 + h * 256 + q * 64 + vc;
    bf16x8 k00, k01, k10, k11, v0;
    const bf16* kp = Kg + (size_t)sr * 1024; const bf16* vp = Vg + (size_t)vr * 1024;
#define SLOAD(k0) do { asm volatile("" : "+v"(kp), "+v"(vp)); k00 = *(const bf16x8*)(kp); k01 = *(const bf16x8*)(kp + 128); k10 = *(const bf16x8*)(kp + 32 * 1024); k11 = *(const bf16x8*)(kp + 32 * 1024 + 128); \
        v0 = *(const bf16x8*)(vp); kp += 64 * 1024; vp += 64 * 1024; } while (0)
#define SWRITE(bp) do { *(LAS bf16x8*)((bp) + ks0) = k00; *(LAS bf16x8*)((bp) + 16384 + ks0) = k01; *(LAS bf16x8*)((bp) + ks1) = k10; *(LAS bf16x8*)((bp) + 16384 + ks1) = k11; \
        *(LAS bf16x8*)((bp) + 32768 + vs0) = v0; } while (0)
    f32x16 acc[2] = {};
    const int abase = (int)(uintptr_t)lds + (wid >> 2) * 16384 + (wid & 3) * 512 + v_rd_base(lane);
    const int bbase = (int)(uintptr_t)lds + 32768 + v_rd_base(lane);
    SLOAD(0); SWRITE(lds);
    constexpr int NT = 28;
#pragma unroll 1
    for (int t = 0; t < NT; ++t) {
        const int bo = (t & 1) * RBUF;
        __syncthreads();
        if (t + 1 < NT) SLOAD((t + 1) * 64);
        { s16x4 al[4], ah[4], bl[2][4], bh[2][4];
#pragma unroll
          for (int ks = 0; ks < 4; ++ks) { TRRDV(al[ks], abase + bo, ks * 4096); TRRDV(ah[ks], abase + bo, ks * 4096 + 2048); }
#pragma unroll
          for (int ks = 0; ks < 4; ++ks) { TRRDV(bl[0][ks], bbase + bo, ks * 4096); TRRDV(bh[0][ks], bbase + bo, ks * 4096 + 2048); TRRDV(bl[1][ks], bbase + bo, 512 + ks * 4096); TRRDV(bh[1][ks], bbase + bo, 512 + ks * 4096 + 2048); }
          asm volatile("s_waitcnt lgkmcnt(0)" ::: "memory"); SBAR();
#pragma unroll
          for (int ks = 0; ks < 4; ++ks) { acc[0] = __builtin_amdgcn_mfma_f32_32x32x16_bf16(FR8(al[ks], ah[ks]), FR8(bl[0][ks], bh[0][ks]), acc[0], 0, 0, 0);
              acc[1] = __builtin_amdgcn_mfma_f32_32x32x16_bf16(FR8(al[ks], ah[ks]), FR8(bl[1][ks], bh[1][ks]), acc[1], 0, 0, 0); } }
        if ((t & 3) == 3) {
            int hi2 = hi; asm volatile("" : "+v"(hi2));
            bf16* sp = SBUF + ((size_t)(b * 4 + h) * 7 + (t >> 2)) * SB_STRIDE + (size_t)(wid * 32) * 256 + q * 64;
#pragma unroll
            for (int d = 0; d < 2; ++d)
#pragma unroll
                for (int r = 0; r < 16; ++r) { const float v = acc[d][r]; const float vn = __shfl_xor(v, 1);
                    if ((r32 & 1) == 0) *(unsigned*)(sp + (size_t)crow(r, hi2) * 256 + d * 32 + r32) = cvt_pk_bf16(v, vn); }
        }
        if (t + 1 < NT) { asm volatile("s_waitcnt vmcnt(0)" ::: "memory"); SWRITE(lds + ((t + 1) & 1) * RBUF); }
    }
    __syncthreads();
#undef SLOAD
#undef SWRITE
}

DEV void qkt256(f32x16& p0, f32x16& p1, const LAS char* buf, int r32, int hi, const bf16x8* qr) {
    p0 = f32x16{}; p1 = f32x16{};
#pragma unroll
    for (int cb = 0; cb < 2; ++cb) { const LAS char* kb[4];
#pragma unroll
        for (int dd = 0; dd < 4; ++dd) kb[dd] = buf + cb * 16384 + KSWZ(r32, (dd * 16 + hi * 8) * 2);
#pragma unroll
        for (int d0 = 0; d0 < 8; ++d0) { const LAS char* a = kb[d0 & 3] + (d0 >> 2) * 128;
            const bf16x8 b0 = *(const LAS bf16x8*)a, b1 = *(const LAS bf16x8*)(a + 32 * 256);
            p0 = __builtin_amdgcn_mfma_f32_32x32x16_bf16(b0, qr[cb * 8 + d0], p0, 0, 0, 0);
            p1 = __builtin_amdgcn_mfma_f32_32x32x16_bf16(b1, qr[cb * 8 + d0], p1, 0, 0, 0); } }
}
DEV void pack_p(const f32x16& p0, const f32x16& p1, bf16x8& pa0, bf16x8& pa1, bf16x8& pa2, bf16x8& pa3) {
#define PK4(P, B_, OUT) do { unsigned a0 = cvt_pk_bf16(P[B_+0], P[B_+1]), a1 = cvt_pk_bf16(P[B_+2], P[B_+3]);                          \
        unsigned b0 = cvt_pk_bf16(P[B_+4], P[B_+5]), b1 = cvt_pk_bf16(P[B_+6], P[B_+7]);                                             \
        auto r0 = __builtin_amdgcn_permlane32_swap(a0, b0, false, false); auto r1 = __builtin_amdgcn_permlane32_swap(a1, b1, false, false); \
        u32x4 w = {r0[0], r1[0], r0[1], r1[1]}; OUT = __builtin_bit_cast(bf16x8, w); } while (0)
    PK4(p0, 0, pa0); PK4(p0, 8, pa1); PK4(p1, 0, pa2); PK4(p1, 8, pa3);
#undef PK4
}
DEV void ret_unit(int b, int h, int n, const bf16* RQ, const bf16* RK, const bf16* RV, const bf16* SBUF, bf16* YR, LAS char* lds, int wid) {
    const int lane = lane_id(), r32 = lane & 31, hi = lane >> 5;
    const size_t rowb = (size_t)b * SEQ; const int q0 = n * 256;
    bf16x8 qr[16];
    { const bf16* qp = RQ + (rowb + q0 + wid * 32 + r32) * 1024 + h * 256 + hi * 8;
#pragma unroll
      for (int d0 = 0; d0 < 16; ++d0) qr[d0] = *(const bf16x8*)(qp + d0 * 16); }
    const int qlo = q0 + wid * 32, qm = qlo + r32 - 4 * hi;
    const int vbase = (int)(uintptr_t)lds + 32768 + v_rd_base(lane);
    const int NS = (n > 0) ? 8 : 4;
    const int kr = 4 * wid + (lane >> 4), kc = ((lane & 15) ^ (kr & 7)) * 8;
    const int vsub = 2 * wid + (lane >> 5), vkk = (vsub >> 2) * 8 + ((lane & 31) >> 2), vkey = (vkk & ~0xC) | ((vkk & 4) << 1) | ((vkk & 8) >> 1), vcol = (vsub & 3) * 32 + (lane & 3) * 8;
#pragma unroll 1
    for (int half = 0; half < 2; ++half) {
        const bf16* kp = RK + (rowb + q0 + kr) * 1024 + h * 256 + kc; const bf16* vp = RV + (rowb + q0 + vkey) * 1024 + h * 256 + half * 128 + vcol;
        const bf16* sp = SBUF + ((size_t)(b * 4 + h) * 7 + (n - 1)) * SB_STRIDE + (size_t)vkey * 256 + half * 128 + vcol;
#define GLDS(g, l) __builtin_amdgcn_global_load_lds((const unsigned*)(g), (LAS unsigned*)(l), 16, 0, 0)
#define STAGE(bp, s) do { LAS char* d_ = (bp) + wid * 1024; if ((s) < 4) { asm volatile("" : "+v"(kp), "+v"(vp)); \
            GLDS(kp, d_); GLDS(kp + 32 * 1024, d_ + 8192); GLDS(kp + 128, d_ + 16384); GLDS(kp + 32 * 1024 + 128, d_ + 16384 + 8192); \
            GLDS(vp, d_ + 32768); GLDS(vp + 32 * 1024, d_ + 32768 + 8192); kp += 64 * 1024; vp += 64 * 1024; } \
          else { asm volatile("" : "+v"(sp)); GLDS(sp, d_ + 32768); GLDS(sp + 32 * 256, d_ + 32768 + 8192); sp += 64 * 256; } } while (0)
        f32x16 o[4] = {};
        __syncthreads();
        STAGE(lds, 0);
#pragma unroll 1
        for (int s = 0; s < NS; ++s) {
            const int bo = (s & 1) * RBUF;
            asm volatile("s_waitcnt vmcnt(0)" ::: "memory");
            __syncthreads();
            if (s + 1 < NS) STAGE(lds + (bo ^ RBUF), s + 1);
            if (s < 4) {
                const int kb = q0 + s * 64;
                if (kb <= qlo + 31) {
                    f32x16 p0, p1; bf16x8 pa0, pa1, pa2, pa3;
                    qkt256(p0, p1, lds + bo, r32, hi, qr);
                    if (kb + 63 > qlo) { const int dq = qm - kb;
#pragma unroll
                        for (int r = 0; r < 16; ++r) { const int c = (r & 3) + 8 * (r >> 2); if (dq - c < 0) p0[r] = 0.f; if (dq - c - 32 < 0) p1[r] = 0.f; } }
                    pack_p(p0, p1, pa0, pa1, pa2, pa3); SBAR();
                    mla::pv_tile(o, vbase + bo, pa0, pa1, pa2, pa3);
                }
            } else {
                const int c = s - 4;
                if (c == 0) mla::pv_tile(o, vbase + bo, qr[0], qr[1], qr[2], qr[3]);
                else if (c == 1) mla::pv_tile(o, vbase + bo, qr[4], qr[5], qr[6], qr[7]);
                else if (c == 2) mla::pv_tile(o, vbase + bo, qr[8], qr[9], qr[10], qr[11]);
                else mla::pv_tile(o, vbase + bo, qr[12], qr[13], qr[14], qr[15]);
            }
        }
        int hi2 = hi, c32 = r32; asm volatile("" : "+v"(hi2), "+v"(c32));
        bf16* Ow = YR + (rowb + q0 + wid * 32) * 1024 + h * 256 + half * 128 + c32;
#pragma unroll
        for (int r = 0; r < 16; ++r) { const int orow = crow(r, hi2);
#pragma unroll
            for (int d0 = 0; d0 < 4; ++d0) { const float v = o[d0][r]; const float vn = __shfl_xor(v, 1);
                if ((r32 & 1) == 0) *(unsigned*)(Ow + (size_t)orow * 1024 + d0 * 32) = cvt_pk_bf16(v, vn); } }
#undef STAGE
#undef GLDS
    }
    __syncthreads();
}
#undef KSWZ
#undef SBAR
#undef TRRDV
#undef FR8
}
DEV void cvt_block(const float* W, int ldw, int sc0, int k0, bf16* WT, int K, int dr0, const float* gain, LAS float* scr, int lane) {
#pragma unroll 8
    for (int i = 0; i < 32; ++i) { const int kk = 2 * i + (lane >> 5); float v = 0.f;
        if (sc0 >= 0) { v = W[(size_t)(k0 + kk) * ldw + sc0 + (lane & 31)]; if (gain) v *= gain[k0 + kk]; }
        scr[kk * 33 + (lane & 31)] = v; }
    LDS_WAIT(); asm volatile("" ::: "memory");
    const int c = lane & 7;
#pragma unroll
    for (int j = 0; j < 4; ++j) { const int n = (lane >> 3) + 8 * j; const LAS float* s = scr + (8 * c) * 33 + n;
        u32x4 o; o.x = pk2(s[0 * 33], s[1 * 33]); o.y = pk2(s[2 * 33], s[3 * 33]); o.z = pk2(s[4 * 33], s[5 * 33]); o.w = pk2(s[6 * 33], s[7 * 33]);
        *(u32x4*)(WT + (size_t)(dr0 + n) * K + k0 + 8 * c) = o; }
    LDS_WAIT(); asm volatile("" ::: "memory");
}
DEV int win1_src(int db) {
    if (db < 96) return db * 32;
    if (db < 104) return C_CQ + (db - 96) * 32;
    if (db < 108) return C_CQ + 256 + (db - 104) * 32;
    if (db < 110) return C_KPE + (db - 108) * 32;
    if (db < 112) return -1;
    return C_CKV + (db - 112) * 32;
}
DEV int wuq_src(int db) {
    const int t = db >> 3, j = db & 7;
    if (t < 4) { const int head = 2 * t + (j >> 2); return 192 * head + 32 * (j & 3); }
    const int head = 4 * (t - 4) + (j & 3); return 192 * head + 128 + 32 * (j >> 2);
}

struct MkArgs { const float* in[22]; float* out; unsigned char* ws; int ph_lo, ph_hi, li, pad; };

struct EpiP1 {
    static constexpr bool PERM = true;
    bf16 *RQ, *RK, *RV, *CQ, *CKV, *KPE; const float* rope;
    DEV void operator()(const f32x4 (&acc)[2][2][4][2], const pg8::Unit& u, int wr, int wc, int fr, int fq) const {
        { const int l_ = lane_id(); fr = l_ & 15; fq = l_ >> 4; }
        const int row0 = u.pm * 256 + wr * 64 + fr, c8 = wc * 32 + 8 * fq;
        if (u.pn < 8) {
            bf16* dst = (u.pn < 4 ? RQ : RK) + (u.pn & 3) * 256 + c8;
            const float lg = __log2f(1.f - exp2f(-5.f - (float)(u.pn & 3))) * (u.pn < 4 ? 1.f : -1.f), s16 = u.pn < 4 ? 1.f : 0.0625f;
#pragma unroll
            for (int ai = 0; ai < 2; ++ai)
#pragma unroll
                for (int m = 0; m < 4; ++m) { const int row = row0 + ai * 128 + m * 16; const float* cp = rope + (size_t)(row & 2047) * 128 + c8; const float sc = exp2f(lg * (float)((row & 2047) - 1024)) * s16;
                    const f32x4 c0 = *(const f32x4*)cp, c1 = *(const f32x4*)(cp + 4), s0 = *(const f32x4*)(cp + 2048 * 128), s1 = *(const f32x4*)(cp + 2048 * 128 + 4);
                    const f32x4 a0 = acc[ai][0][m][0], a1 = acc[ai][0][m][1], b0 = acc[ai][1][m][0], b1 = acc[ai][1][m][1];
                    const f32x4 o0 = (a0 * c0 - b0 * s0) * sc, o1 = (a1 * c1 - b1 * s1) * sc, p0 = (b0 * c0 + a0 * s0) * sc, p1 = (b1 * c1 + a1 * s1) * sc;
                    u32x4 w; w.x = cvt_pk_bf16(o0[0], o0[1]); w.y = cvt_pk_bf16(o0[2], o0[3]); w.z = cvt_pk_bf16(o1[0], o1[1]); w.w = cvt_pk_bf16(o1[2], o1[3]);
                    *(u32x4*)(dst + (size_t)row * 1024) = w;
                    w.x = cvt_pk_bf16(p0[0], p0[1]); w.y = cvt_pk_bf16(p0[2], p0[3]); w.z = cvt_pk_bf16(p1[0], p1[1]); w.w = cvt_pk_bf16(p1[2], p1[3]);
                    *(u32x4*)(dst + (size_t)row * 1024 + 128) = w; }
        } else {
            bf16* d0; bf16* d1; int ld; bool ok1 = true;
            if (u.pn < 12) { d0 = RV + (u.pn - 8) * 256 + c8; d1 = d0 + 128; ld = 1024; }
            else if (u.pn == 12) { d0 = CQ + c8; d1 = d0 + 128; ld = 384; }
            else if (u.pn == 14) { d0 = CKV + c8; d1 = d0 + 128; ld = 256; }
            else { d0 = CQ + 256 + c8; d1 = KPE + c8; ld = 384; ok1 = (wc < 2); }
            const int ld1 = (u.pn == 13) ? 64 : ld;
#pragma unroll
            for (int ai = 0; ai < 2; ++ai)
#pragma unroll
                for (int m = 0; m < 4; ++m) { const int row = row0 + ai * 128 + m * 16;
                    const f32x4 a0 = acc[ai][0][m][0], a1 = acc[ai][0][m][1], b0 = acc[ai][1][m][0], b1 = acc[ai][1][m][1];
                    u32x4 w; w.x = cvt_pk_bf16(a0[0], a0[1]); w.y = cvt_pk_bf16(a0[2], a0[3]); w.z = cvt_pk_bf16(a1[0], a1[1]); w.w = cvt_pk_bf16(a1[2], a1[3]);
                    *(u32x4*)(d0 + (size_t)row * ld) = w;
                    if (ok1) { w.x = cvt_pk_bf16(b0[0], b0[1]); w.y = cvt_pk_bf16(b0[2], b0[3]); w.z = cvt_pk_bf16(b1[0], b1[1]); w.w = cvt_pk_bf16(b1[2], b1[3]);
                        *(u32x4*)(d1 + (size_t)row * ld1) = w; } }
        }
    }
};
struct SchedP1 {
    const char* A; const char* B; int G, c, nN;
    DEV bool next(int i, pg8::Unit& u) const { int pm, pn; if (!pg8::static_tile(i, G, c, M / 256, nN, pm, pn)) return false;
        u.pm = pm; u.pn = pn; u.kind = 0; u.A = A + (size_t)pm * 256 * 1024 * 2; u.B = B + (size_t)pn * 256 * 1024 * 2; return true; }
};


struct EpiQ {
    static constexpr bool PERM = true;
    bf16* Q; const float* rs; const float* rope;
    DEV void operator()(const f32x4 (&acc)[2][2][4][2], const pg8::Unit& u, int wr, int wc, int fr, int fq) const {
        { const int l_ = lane_id(); fr = l_ & 15; fq = l_ >> 4; }
        const int row0 = u.pm * 256 + wr * 64 + fr, c8 = wc * 32 + 8 * fq;
#pragma unroll
        for (int ai = 0; ai < 2; ++ai)
#pragma unroll
            for (int m = 0; m < 4; ++m) { const int row = row0 + ai * 128 + m * 16; const float r = rs[row];
                const f32x4 a0 = acc[ai][0][m][0] * r, a1 = acc[ai][0][m][1] * r, b0 = acc[ai][1][m][0] * r, b1 = acc[ai][1][m][1] * r;
                if (u.pn < 4) {
                    bf16* d = Q + (size_t)row * 1536 + (2 * u.pn) * 192 + c8;
                    u32x4 w; w.x = cvt_pk_bf16(a0[0], a0[1]); w.y = cvt_pk_bf16(a0[2], a0[3]); w.z = cvt_pk_bf16(a1[0], a1[1]); w.w = cvt_pk_bf16(a1[2], a1[3]);
                    *(u32x4*)d = w;
                    w.x = cvt_pk_bf16(b0[0], b0[1]); w.y = cvt_pk_bf16(b0[2], b0[3]); w.z = cvt_pk_bf16(b1[0], b1[1]); w.w = cvt_pk_bf16(b1[2], b1[3]);
                    *(u32x4*)(d + 192) = w;
                } else {
                    const float* cp = rope + (size_t)(row & 2047) * 32 + 8 * fq;
                    const f32x4 c0 = *(const f32x4*)cp, c1 = *(const f32x4*)(cp + 4), s0 = *(const f32x4*)(cp + 2048 * 32), s1 = *(const f32x4*)(cp + 2048 * 32 + 4);
                    const f32x4 o0 = a0 * c0 - b0 * s0, o1 = a1 * c1 - b1 * s1, p0 = b0 * c0 + a0 * s0, p1 = b1 * c1 + a1 * s1;
                    bf16* d = Q + (size_t)row * 1536 + (4 * (u.pn - 4) + wc) * 192 + 128 + 8 * fq;
                    u32x4 w; w.x = cvt_pk_bf16(o0[0], o0[1]); w.y = cvt_pk_bf16(o0[2], o0[3]); w.z = cvt_pk_bf16(o1[0], o1[1]); w.w = cvt_pk_bf16(o1[2], o1[3]);
                    *(u32x4*)d = w;
                    w.x = cvt_pk_bf16(p0[0], p0[1]); w.y = cvt_pk_bf16(p0[2], p0[3]); w.z = cvt_pk_bf16(p1[0], p1[1]); w.w = cvt_pk_bf16(p1[2], p1[3]);
                    *(u32x4*)(d + 32) = w;
                }
                asm volatile("" ::: "memory"); }
    }
};
struct EpiPlain {
    static constexpr bool PERM = true;
    bf16* O; int ldc; const float* rs;
    DEV void operator()(const f32x4 (&acc)[2][2][4][2], const pg8::Unit& u, int wr, int wc, int fr, int fq) const {
        { const int l_ = lane_id(); fr = l_ & 15; fq = l_ >> 4; }
        const int row0 = u.pm * 256 + wr * 64 + fr, c8 = u.pn * 256 + wc * 32 + 8 * fq;
#pragma unroll
        for (int ai = 0; ai < 2; ++ai)
#pragma unroll
            for (int m = 0; m < 4; ++m) { const int row = row0 + ai * 128 + m * 16; const float r = rs ? rs[row] : 1.f;
#pragma unroll
                for (int bj = 0; bj < 2; ++bj) { const f32x4 a0 = acc[ai][bj][m][0] * r, a1 = acc[ai][bj][m][1] * r;
                    u32x4 w; w.x = cvt_pk_bf16(a0[0], a0[1]); w.y = cvt_pk_bf16(a0[2], a0[3]); w.z = cvt_pk_bf16(a1[0], a1[1]); w.w = cvt_pk_bf16(a1[2], a1[3]);
                    *(u32x4*)(O + (size_t)row * ldc + c8 + bj * 128) = w; }
                asm volatile("" ::: "memory"); }
    }
};
DEV f32x4 bflo4(unsigned a, unsigned b) { return (f32x4){__uint_as_float(a << 16), __uint_as_float(a & 0xffff0000u), __uint_as_float(b << 16), __uint_as_float(b & 0xffff0000u)}; }
DEV f32x4 silu4(f32x4 v) { return (f32x4){silu_f(v[0]), silu_f(v[1]), silu_f(v[2]), silu_f(v[3])}; }
DEV f32x4 sigm4(f32x4 v) { return (f32x4){sigmoid_f(v[0]), sigmoid_f(v[1]), sigmoid_f(v[2]), sigmoid_f(v[3])}; }
struct EpiRg {
    static constexpr bool PERM = true;
    bf16* YR; LAS f32x2* ex;
    DEV void operator()(const f32x4 (&acc)[2][2][4][2], const pg8::Unit& u, int wr, int wc, int fr, int fq) const {
        { const int l_ = lane_id(); fr = l_ & 15; fq = l_ >> 4; }
        const int row0 = u.pm * 256 + wr * 64 + fr, c8 = u.pn * 256 + wc * 32 + 8 * fq;
#pragma unroll
        for (int ai = 0; ai < 2; ++ai)
#pragma unroll
            for (int m = 0; m < 4; ++m) { float s = 0.f, q = 0.f;
#pragma unroll
                for (int bj = 0; bj < 2; ++bj) { const u32x4 yy = *(const u32x4*)(YR + (size_t)(row0 + ai * 128 + m * 16) * 1024 + c8 + bj * 128);
                    const f32x4 v0 = bflo4(yy.x, yy.y), v1 = bflo4(yy.z, yy.w);
                    s += (v0[0] + v0[1]) + (v0[2] + v0[3]) + (v1[0] + v1[1]) + (v1[2] + v1[3]);
                    q += (v0[0] * v0[0] + v0[1] * v0[1]) + (v0[2] * v0[2] + v0[3] * v0[3]) + (v1[0] * v1[0] + v1[1] * v1[1]) + (v1[2] * v1[2] + v1[3] * v1[3]); }
                s += __shfl_xor(s, 16); s += __shfl_xor(s, 32); q += __shfl_xor(q, 16); q += __shfl_xor(q, 32);
                if (fq == 0) ex[(ai * 128 + wr * 64 + m * 16 + fr) * 4 + wc] = (f32x2){s, q};
                if (m & 1) asm volatile("" ::: "memory"); }
        asm volatile("s_waitcnt lgkmcnt(0)" ::: "memory"); __builtin_amdgcn_s_barrier(); asm volatile("" ::: "memory");
#pragma unroll
        for (int ai = 0; ai < 2; ++ai)
#pragma unroll
            for (int m = 0; m < 4; ++m) { const int rl = ai * 128 + wr * 64 + m * 16 + fr;
                const f32x2 p0 = ex[rl * 4 + 0], p1 = ex[rl * 4 + 1], p2 = ex[rl * 4 + 2], p3 = ex[rl * 4 + 3];
                const float mu = ((p0.x + p1.x) + (p2.x + p3.x)) * (1.f / 256.f), ms = ((p0.y + p1.y) + (p2.y + p3.y)) * (1.f / 256.f);
                const float rstd = rsqrtf(fmaxf(ms - mu * mu, 0.f) + EPS);
#pragma unroll
                for (int bj = 0; bj < 2; ++bj) { const u32x4 yy = *(const u32x4*)(YR + (size_t)(row0 + ai * 128 + m * 16) * 1024 + c8 + bj * 128);
                    const f32x4 v0 = bflo4(yy.x, yy.y), v1 = bflo4(yy.z, yy.w);
                    const f32x4 o0 = silu4(acc[ai][bj][m][0]) * ((v0 - mu) * rstd), o1 = silu4(acc[ai][bj][m][1]) * ((v1 - mu) * rstd);
                    u32x4 w; w.x = cvt_pk_bf16(o0[0], o0[1]); w.y = cvt_pk_bf16(o0[2], o0[3]); w.z = cvt_pk_bf16(o1[0], o1[1]); w.w = cvt_pk_bf16(o1[2], o1[3]);
                    *(u32x4*)(YR + (size_t)(row0 + ai * 128 + m * 16) * 1024 + c8 + bj * 128) = w; }
                if (m & 1) asm volatile("" ::: "memory"); }
        asm volatile("s_waitcnt lgkmcnt(0)" ::: "memory"); __builtin_amdgcn_s_barrier(); asm volatile("" ::: "memory");
    }
};
struct EpiMerge {
    static constexpr bool PERM = true;
    bf16* SA; bf16* SB; bf16* MG;
    template <int KIND> DEV void run(const f32x4 (&acc)[2][2][4][2], const pg8::Unit& u, int wr, int wc, int fr, int fq) const {
        const int row0 = u.pm * 256 + wr * 64 + fr, c8 = u.pn * 256 + wc * 32 + 8 * fq;
        const size_t sbase = (size_t)blockIdx.x * 65536 + (size_t)(((wr * 4 + wc) * 64 + fq * 16 + fr) * 8);
#pragma unroll
        for (int ai = 0; ai < 2; ++ai)
#pragma unroll
            for (int m = 0; m < 4; ++m) {
#pragma unroll
                for (int bj = 0; bj < 2; ++bj) { const size_t so = sbase + (size_t)((ai * 4 + m) * 2 + bj) * 4096;
                    f32x4 a0 = acc[ai][bj][m][0], a1 = acc[ai][bj][m][1];
                    if (KIND == 0 || KIND == 2) { a0 = sigm4(a0); a1 = sigm4(a1); }
                    else if (KIND == 1) { const u32x4 t = *(const u32x4*)(SA + so); a0 = a0 * bflo4(t.x, t.y); a1 = a1 * bflo4(t.z, t.w); }
                    else { const u32x4 t = *(const u32x4*)(SA + so), g = *(const u32x4*)(SB + so); a0 = bflo4(t.x, t.y) + a0 * bflo4(g.x, g.y); a1 = bflo4(t.z, t.w) + a1 * bflo4(g.z, g.w); }
                    u32x4 w; w.x = cvt_pk_bf16(a0[0], a0[1]); w.y = cvt_pk_bf16(a0[2], a0[3]); w.z = cvt_pk_bf16(a1[0], a1[1]); w.w = cvt_pk_bf16(a1[2], a1[3]);
                    if (KIND == 3) *(u32x4*)(MG + (size_t)(row0 + ai * 128 + m * 16) * 1024 + c8 + bj * 128) = w;
                    else *(u32x4*)((KIND == 2 ? SB : SA) + so) = w; }
                asm volatile("" ::: "memory"); }
    }
    DEV void operator()(const f32x4 (&acc)[2][2][4][2], const pg8::Unit& u, int wr, int wc, int fr, int fq) const {
        { const int l_ = lane_id(); fr = l_ & 15; fq = l_ >> 4; }
        if (u.kind == 0) run<0>(acc, u, wr, wc, fr, fq); else if (u.kind == 1) run<1>(acc, u, wr, wc, fr, fq); else if (u.kind == 2) run<2>(acc, u, wr, wc, fr, fq); else run<3>(acc, u, wr, wc, fr, fq);
    }
};
struct EpiOut {
    static constexpr bool PERM = true;
    const float* x; const float* mod; float* H;
    DEV void operator()(const f32x4 (&acc)[2][2][4][2], const pg8::Unit& u, int wr, int wc, int fr, int fq) const {
        { const int l_ = lane_id(); fr = l_ & 15; fq = l_ >> 4; }
        const int row0 = u.pm * 256 + wr * 64 + fr, c8 = u.pn * 256 + wc * 32 + 8 * fq;
        const float* gp = mod + (size_t)((u.pm * 256) / SEQ) * 6144 + 2048 + c8;
        f32x4 g[2][2];
#pragma unroll
        for (int bj = 0; bj < 2; ++bj) { g[bj][0] = *(const f32x4*)(gp + bj * 128); g[bj][1] = *(const f32x4*)(gp + bj * 128 + 4); }
#pragma unroll
        for (int ai = 0; ai < 2; ++ai)
#pragma unroll
            for (int m = 0; m < 4; ++m)
#pragma unroll
                for (int bj = 0; bj < 2; ++bj) { const size_t o = (size_t)(row0 + ai * 128 + m * 16) * 1024 + c8 + bj * 128;
                    const f32x4 x0 = *(const f32x4*)(x + o), x1 = *(const f32x4*)(x + o + 4);
                    *(f32x4*)(H + o) = x0 + g[bj][0] * acc[ai][bj][m][0]; *(f32x4*)(H + o + 4) = x1 + g[bj][1] * acc[ai][bj][m][1]; }
    }
};
struct SchedG {
    const char* A; const char* B; int G, c, nN, K;
    DEV bool next(int i, pg8::Unit& u) const { int pm, pn; if (!pg8::static_tile(i, G, c, M / 256, nN, pm, pn)) return false;
        u.pm = pm; u.pn = pn; u.kind = 0; u.A = A + (size_t)pm * 256 * K * 2; u.B = B + (size_t)pn * 256 * K * 2; return true; }
};
struct SchedMerge {
    const char* ws; int G, c;
    DEV bool next(int i, pg8::Unit& u) const { if (i >= 4) return false; int pm, pn; if (!pg8::static_tile(0, G, c, M / 256, 4, pm, pn)) return false;
        u.pm = pm; u.pn = pn; u.kind = i; const size_t ao = (size_t)pm * 256 * 1024 * 2, bo = (size_t)pn * 256 * 1024 * 2;
        const size_t aoff = S0 + (i == 1 ? (S5 - S0) : 0) + (i == 3 ? (S6 - S0) : 0);
        const size_t boff = WS_WGR + (size_t)i * (2 * MiB);
        u.A = ws + aoff + ao; u.B = ws + boff + bo; return true; }
};
static_assert(WS_WRETO == WS_WGR + 2 * MiB && WS_WGM == WS_WGR + 4 * MiB && WS_WMLAO == WS_WGR + 6 * MiB, "weight copy order");


constexpr size_t WS_CNT_WORD = 2048;
constexpr size_t WS_RIDX = WS_ROUTE + 512 * 1024;
constexpr size_t WS_SLOT = WS_ROUTE + 768 * 1024;
constexpr size_t WS_TOK = 7 * MiB;
constexpr size_t WS_GATE = 7 * MiB + 256 * 1024;
constexpr size_t WS_W13 = 96 * MiB;
constexpr size_t WS_W2T = 128 * MiB;
constexpr size_t WS_HID = 144 * MiB;
constexpr size_t WS_Y = 164 * MiB;
constexpr int TP_OFF = EX_OFF + 4096;
DEV void moe_tile_prefix(const unsigned* cnt, LAS int* tp, int tid) {
    __syncthreads();
    if (tid == 0) { int s = 0; for (int e = 0; e < 32; ++e) { tp[e] = s; s += ((int)cnt[e] + 255) >> 8; } tp[32] = s; }
    __syncthreads();
}
DEV int moe_expert_of_tile(const LAS int* tp, int tile) { int e = 0;
#pragma unroll 1
    for (int q = 1; q < 32; ++q) e = (tp[q] <= tile) ? q : e;
    return e; }
struct SchedUp {
    const char* U2; const char* W13; const int* TOK; const LAS int* tp; int G, c;
    DEV bool next(int i, pg8::Unit& u) const { const int j = i * G + c; if (j >= 2 * tp[32]) return false; const int tile = j >> 1, pn = j & 1, e = moe_expert_of_tile(tp, tile);
        u.pm = tile; u.pn = pn; u.kind = 0; u.A = U2; u.tok = TOK + tile * 256; u.B = W13 + ((size_t)e * 512 + pn * 256) * 2048; return true; }
};
struct SchedDown {
    const char* HID; const char* W2T; const LAS int* tp; int G, c;
    DEV bool next(int i, pg8::Unit& u) const { const int j = i * G + c; if (j >= 4 * tp[32]) return false; const int tile = j >> 2, pn = j & 3, e = moe_expert_of_tile(tp, tile);
        u.pm = tile; u.pn = pn; u.kind = 0; u.tok = nullptr; u.A = HID + (size_t)tile * 256 * 512; u.B = W2T + ((size_t)e * 1024 + pn * 256) * 512; return true; }
};
struct EpiUp {
    static constexpr bool PERM = true;
    bf16* HID; const float* GATE;
    DEV void operator()(const f32x4 (&acc)[2][2][4][2], const pg8::Unit& u, int wr, int wc, int fr, int fq) const {
        { const int l_ = lane_id(); fr = l_ & 15; fq = l_ >> 4; }
        const int row0 = u.pm * 256 + wr * 64 + fr, c8 = u.pn * 128 + wc * 32 + 8 * fq;
#pragma unroll
        for (int ai = 0; ai < 2; ++ai)
#pragma unroll
            for (int m = 0; m < 4; ++m) { const int row = row0 + ai * 128 + m * 16; const float g = GATE[row];
                const f32x4 o0 = silu4(acc[ai][0][m][0]) * acc[ai][1][m][0] * g, o1 = silu4(acc[ai][0][m][1]) * acc[ai][1][m][1] * g;
                u32x4 w; w.x = cvt_pk_bf16(o0[0], o0[1]); w.y = cvt_pk_bf16(o0[2], o0[3]); w.z = cvt_pk_bf16(o1[0], o1[1]); w.w = cvt_pk_bf16(o1[2], o1[3]);
                *(u32x4*)(HID + (size_t)row * 256 + c8) = w;
                if (m & 1) asm volatile("" ::: "memory"); }
    }
};

__global__ void __launch_bounds__(NWAVES * 64, 2) mk_fwd(MkArgs args) {
    extern __shared__ __attribute__((aligned(16))) unsigned char lds_raw[];
    LAS unsigned char* lds = (LAS unsigned char*)lds_raw;
    volatile LAS unsigned* MISC = (volatile LAS unsigned*)(lds + MISC_OFF);
    const int wave = __builtin_amdgcn_readfirstlane(threadIdx.x >> 6);
#define lane (lane_id())
#define tid (wave * 64 + lane_id())
    const int G = gridDim.x; const int bx = blockIdx.x; const int vcu = (G % 8 == 0) ? (bx % 8) * (G / 8) + bx / 8 : bx;
    unsigned char* ws = args.ws;
    unsigned* ctl = (unsigned*)(ws + WS_CTL);
    for (int u = tid; u < (LDS_BYTES - LDSCTL_OFF) / 4; u += NWAVES * 64) ((LAS unsigned*)(lds + LDSCTL_OFF))[u] = 0u;
    __syncthreads();
    XcdBarrier bar = xcd_barrier_post(ctl + CW_BAR + args.li * XCD_BAR_WORDS, MISC + 8);
    const int lo = args.ph_lo, hi = args.ph_hi;
#ifndef PHMASK
#define PHMASK 0xffffffffu
#endif
#define IN(k) ((((PHMASK) >> (k)) & 1u) && lo <= (k) && (k) < hi)
#define SEAM(k) do { if (IN(k) && IN((k) + 1)) xcd_barrier(bar); } while (0)
    const float* x = args.in[0]; const float* cvec = args.in[1]; const float* w_ada = args.in[2]; const float* b_ada = args.in[3];
    const float* norm1 = args.in[4]; const float* w_in = args.in[6]; const float* w_ret_o = args.in[7];
    const float* q_norm = args.in[8]; const float* kv_norm = args.in[9]; const float* w_uq = args.in[10]; const float* w_ukv = args.in[11];
    const float* w_mla_o = args.in[12]; const float* w_out = args.in[13]; const float* norm2 = args.in[5]; const float* w_grp = args.in[14]; const float* b_grp = args.in[15];
    const float* w_exp = args.in[16]; const float* b_exp = args.in[17]; const float* w1 = args.in[18]; const float* w3 = args.in[19]; const float* w2 = args.in[20]; const float* fnorm = args.in[21];
    bf16* SBUFp = (bf16*)(ws + S6);
    bf16* U2 = (bf16*)(ws + S0); Route* ROUTE = (Route*)(ws + WS_ROUTE);
    float* MOD = (float*)(ws + WS_MOD); float* MODP = (float*)(ws + WS_MODP);
    float* ROPE_RET = (float*)(ws + WS_ROPE_RET); float* ROPE_MLA = (float*)(ws + WS_ROPE_MLA);
    bf16* XN = (bf16*)(ws + S0); bf16* RQ = (bf16*)(ws + S1); bf16* RK = (bf16*)(ws + S2); bf16* RV = (bf16*)(ws + S3);
    bf16* CQ = (bf16*)(ws + S4); bf16* CKV = (bf16*)(ws + S4 + 12 * MiB); bf16* KPE = (bf16*)(ws + S4 + 20 * MiB);
    float* RSQ = (float*)(ws + WS_RS_Q); float* RSKV = (float*)(ws + WS_RS_KV);
    bf16* YR = (bf16*)(ws + S5); bf16* Qb = (bf16*)(ws + S1); bf16* KVB = (bf16*)args.out; bf16* ATT = (bf16*)(ws + S6); bf16* MG = (bf16*)(ws + S1); float* Hf = args.out;
    const int gw = vcu * NWAVES + wave, NGW = G * NWAVES;

    if (IN(0)) {
        LAS float* scr = (LAS float*)(lds + wave * 16384);
        constexpr int I_WIN = 120 * 16, I_SQ = 32 * 16, I_UQ = 48 * 6, I_UKV = 64 * 4;
        constexpr int NITEMS = I_WIN + 6 * I_SQ + I_UQ + I_UKV;
        for (int it = gw; it < NITEMS; it += NGW) {
            int r = it;
            if (r < I_WIN) { const int db = r % 120, kb = r / 120; cvt_block(w_in, IN_W, win1_src(db), kb * 64, (bf16*)(ws + WS_WIN), 1024, db * 32, nullptr, scr, lane); continue; } r -= I_WIN;
            if (r < 3 * I_SQ) { const int w = r / I_SQ, q = r % I_SQ, db = q % 32, kb = q / 32; const int c0 = (w == 0 ? C_RG : w == 1 ? C_GR : C_GM);
                cvt_block(w_in, IN_W, c0 + db * 32, kb * 64, (bf16*)(ws + (w == 0 ? WS_WRG : w == 1 ? WS_WGR : WS_WGM)), 1024, db * 32, nullptr, scr, lane); continue; } r -= 3 * I_SQ;
            if (r < 3 * I_SQ) { const int w = r / I_SQ, q = r % I_SQ, db = q % 32, kb = q / 32;
                cvt_block(w == 0 ? w_ret_o : w == 1 ? w_mla_o : w_out, 1024, db * 32, kb * 64, (bf16*)(ws + (w == 0 ? WS_WRETO : w == 1 ? WS_WMLAO : WS_WOUT)), 1024, db * 32, nullptr, scr, lane); continue; } r -= 3 * I_SQ;
            if (r < I_UQ) { const int db = r % 48, kb = r / 48; cvt_block(w_uq, 1536, wuq_src(db), kb * 64, (bf16*)(ws + WS_WUQ), 384, db * 32, q_norm, scr, lane); continue; } r -= I_UQ;
            { const int db = r % 64, kb = r / 64; cvt_block(w_ukv, 2048, db * 32, kb * 64, (bf16*)(ws + WS_WUKV), 256, db * 32, kv_norm, scr, lane); }
        }
        for (int idx = vcu * 512 + tid; idx < 2048 * 128; idx += G * 512) {
            { const int pos = idx >> 7, i = idx & 127; const float inv = exp2f(-(float)(2 * i) * (13.287712379549449f / 256.f)); float s, c; sincosf((float)pos * inv, &s, &c);
              ROPE_RET[idx] = c; ROPE_RET[2048 * 128 + idx] = s; }
            if (idx < 2048 * 32) { const int pos = idx >> 5, i = idx & 31; const float inv = exp2f(-(float)(2 * i) * (13.287712379549449f / 64.f)); float s, c; sincosf((float)pos * inv, &s, &c);
              ROPE_MLA[idx] = c; ROPE_MLA[2048 * 32 + idx] = s; }
        }
        for (int it = gw; it < 24 * 16; it += NGW) { const int cb = it % 24, kc = it / 24;
#pragma unroll
            for (int b = 0; b < 8; ++b) scr[b * 64 + lane] = silu_f(cvec[b * 1024 + kc * 64 + lane]);
            LDS_WAIT(); asm volatile("" ::: "memory");
            f32x4 a[8];
#pragma unroll
            for (int b = 0; b < 8; ++b) a[b] = (f32x4){0.f, 0.f, 0.f, 0.f};
            const float* wp = w_ada + (size_t)(kc * 64) * 6144 + cb * 256 + lane * 4;
#pragma unroll 8
            for (int kk = 0; kk < 64; ++kk) { const f32x4 w = *(const f32x4*)(wp + (size_t)kk * 6144);
#pragma unroll
                for (int b = 0; b < 8; ++b) a[b] += w * scr[b * 64 + kk]; }
#pragma unroll
            for (int b = 0; b < 8; ++b) *(f32x4*)(MODP + (size_t)(kc * 8 + b) * 6144 + cb * 256 + lane * 4) = a[b];
            LDS_WAIT(); asm volatile("" ::: "memory");
        }
    }
    SEAM(0);
    if (IN(1)) {
        LAS float* shsc = (LAS float*)lds;
        const int b = vcu >> 5;
        { const int col = (tid & 255) * 4, off = (tid >> 8) * 1024; f32x4 s = *(const f32x4*)(b_ada + off + col);
#pragma unroll
          for (int kc = 0; kc < 16; ++kc) s += *(const f32x4*)(MODP + (size_t)(kc * 8 + b) * 6144 + off + col);
          *(LAS f32x4*)(shsc + (tid >> 8) * 1024 + col) = s; }
        if (tid < 192) { const int idx = vcu * 192 + tid, n = idx % 6144, bb = idx / 6144; float s = b_ada[n];
#pragma unroll
            for (int kc = 0; kc < 16; ++kc) s += MODP[(size_t)(kc * 8 + bb) * 6144 + n];
            MOD[idx] = s; }
        __syncthreads();
        f32x4 g[4];
#pragma unroll
        for (int j = 0; j < 4; ++j) g[j] = *(const f32x4*)(norm1 + lane * 4 + 256 * j);
        for (int rr = 0; rr < 8; ++rr) { const int row = vcu * 64 + wave * 8 + rr;
            const f32x4* xr = (const f32x4*)(x + (size_t)row * 1024) + lane; f32x4 v[4]; float ss = 0.f;
#pragma unroll
            for (int j = 0; j < 4; ++j) { v[j] = xr[64 * j]; ss += (v[j].x * v[j].x + v[j].y * v[j].y) + (v[j].z * v[j].z + v[j].w * v[j].w); }
            const float rs = rsqrtf(wave_sum(ss) * (1.f / 1024.f) + EPS);
            unsigned long long* o8 = (unsigned long long*)(XN + (size_t)row * 1024) + lane;
#pragma unroll
            for (int j = 0; j < 4; ++j) { const f32x4 sh = *(LAS f32x4*)(shsc + lane * 4 + 256 * j), sc = *(LAS f32x4*)(shsc + 1024 + lane * 4 + 256 * j);
                const f32x4 y = v[j] * rs * g[j] * (sc + 1.f) + sh;
                o8[64 * j] = (unsigned long long)cvt_pk_bf16(y.x, y.y) | ((unsigned long long)cvt_pk_bf16(y.z, y.w) << 32); }
        }
        __syncthreads();
    }
    SEAM(1);
    if (IN(2)) {
        SchedP1 S{(const char*)XN, (const char*)(ws + WS_WIN), G, bx, 15};
        EpiP1 E{RQ, RK, RV, CQ, CKV, KPE, ROPE_RET};
        pg8::gemm_phase<EpiP1, SchedP1>(lds, wave, 1024, S, E);
    }
    SEAM(2);
    if (IN(3)) {
        if (vcu < 128) ret::scan_unit(vcu >> 4, (vcu >> 2) & 3, vcu & 3, RK, RV, SBUFp, (LAS char*)lds, wave);
        for (int row = gw; row < M; row += NGW) {
            { const unsigned* p = (const unsigned*)(CQ + (size_t)row * 384) + lane; float ss = 0.f;
#pragma unroll
              for (int j = 0; j < 3; ++j) { const unsigned w = p[64 * j]; const float a = __uint_as_float(w << 16), b = __uint_as_float(w & 0xffff0000u); ss += a * a + b * b; }
              ss = wave_sum(ss); if (lane == 0) RSQ[row] = rsqrtf(ss * (1.f / 384.f) + EPS); }
            { const unsigned* p = (const unsigned*)(CKV + (size_t)row * 256) + lane; float ss = 0.f;
#pragma unroll
              for (int j = 0; j < 2; ++j) { const unsigned w = p[64 * j]; const float a = __uint_as_float(w << 16), b = __uint_as_float(w & 0xffff0000u); ss += a * a + b * b; }
              ss = wave_sum(ss); if (lane == 0) RSKV[row] = rsqrtf(ss * (1.f / 256.f) + EPS); }
            if (lane < 32) { bf16* kp = KPE + (size_t)row * 64; const float x1 = bf2f(kp[lane]), x2 = bf2f(kp[lane + 32]);
                const float c = ROPE_MLA[(row & 2047) * 32 + lane], s = ROPE_MLA[2048 * 32 + (row & 2047) * 32 + lane];
                kp[lane] = f2bf(x1 * c - x2 * s); kp[lane + 32] = f2bf(x2 * c + x1 * s); }
        }
    }
    SEAM(3);
    if (IN(4)) {
        ret::ret_unit(vcu >> 5, (vcu >> 3) & 3, vcu & 7, RQ, RK, RV, SBUFp, YR, (LAS char*)lds, wave);
    }
    SEAM(4);
    if (IN(5)) {
        { SchedG S{(const char*)CQ, (const char*)(ws + WS_WUQ), G, bx, 6, 384}; EpiQ E{Qb, RSQ, ROPE_MLA};
          pg8::gemm_phase<EpiQ, SchedG>(lds, wave, 384, S, E); }
        { SchedG S{(const char*)CKV, (const char*)(ws + WS_WUKV), G, G - 1 - bx, 8, 256}; EpiPlain E{KVB, 2048, RSKV};
          pg8::gemm_phase<EpiPlain, SchedG>(lds, wave, 256, S, E); }
    }
    SEAM(5);
    if (IN(6)) {
        { const int bh = vcu >> 2, s = vcu & 3;
          mla::attn_unit(bh >> 3, bh & 7, s * 256, Qb, KVB, KPE, ATT, (LAS char*)lds, wave);
          mla::attn_unit(bh >> 3, bh & 7, (7 - s) * 256, Qb, KVB, KPE, ATT, (LAS char*)lds, wave); }
        SchedG S{(const char*)XN, (const char*)(ws + WS_WRG), G, bx, 4, 1024}; EpiRg E{YR, (LAS f32x2*)(lds + EX_OFF)};
        pg8::gemm_phase<EpiRg, SchedG>(lds, wave, 1024, S, E);
    }
    SEAM(6);
    if (IN(7)) {
        SchedMerge S{(const char*)ws, G, bx};
        EpiMerge E{(bf16*)(ws + S2), (bf16*)(ws + S3), MG};
        pg8::gemm_phase<EpiMerge, SchedMerge>(lds, wave, 1024, S, E);
    }
    SEAM(7);
    if (IN(8)) {
        SchedG S{(const char*)MG, (const char*)(ws + WS_WOUT), G, bx, 4, 1024}; EpiOut E{x, MOD, Hf};
        pg8::gemm_phase<EpiOut, SchedG>(lds, wave, 1024, S, E);
    }
    SEAM(8);
    if (IN(9)) {
        { LAS float* scr = (LAS float*)(lds + wave * 16384);
          for (int it = gw; it < 32 * 384; it += NGW) { const int e = it / 384; int r = it % 384;
              if (r < 256) { const bool is3 = r >= 128; r &= 127; const int nb = r & 7, kb = r >> 3, f0 = nb * 32, dr = (f0 >> 7) * 256 + (f0 & 127) + (is3 ? 128 : 0);
                  cvt_block((is3 ? w3 : w1) + (size_t)e * 1024 * 256, 256, f0, kb * 64, (bf16*)(ws + WS_W13) + (size_t)e * 512 * 1024, 1024, dr, nullptr, scr, lane); }
              else { r -= 256; const int nb = r & 31, kb = r >> 5;
                  cvt_block(w2 + (size_t)e * 256 * 1024, 1024, nb * 32, kb * 64, (bf16*)(ws + WS_W2T) + (size_t)e * 1024 * 256, 256, nb * 32, nullptr, scr, lane); } } }
        LAS unsigned* lcnt = (LAS unsigned*)(lds + EX_OFF); LAS unsigned* wgbase = lcnt + 32; LAS int* lrow = (LAS int*)(lds + EX_OFF + 256);
        __syncthreads();
        if (tid < 32) lcnt[tid] = 0u;
        __syncthreads();
        const int b = vcu >> 5;
        for (int p = 0; p < 2; ++p) {
            const int rbase = vcu * 64 + wave * 8 + p * 4;
            LAS float* ul = (LAS float*)(lds + wave * 16384);
#pragma unroll 1
            for (int rr = 0; rr < 4; ++rr) { const f32x4* hr = (const f32x4*)(Hf + (size_t)(rbase + rr) * 1024) + lane; f32x4 v[4]; float ss = 0.f;
#pragma unroll
                for (int j = 0; j < 4; ++j) { v[j] = hr[64 * j]; ss += (v[j].x * v[j].x + v[j].y * v[j].y) + (v[j].z * v[j].z + v[j].w * v[j].w); }
                const float rs = rsqrtf(wave_sum(ss) * (1.f / 1024.f) + EPS);
                unsigned long long* o8 = (unsigned long long*)(U2 + (size_t)(rbase + rr) * 1024) + lane;
#pragma unroll
                for (int j = 0; j < 4; ++j) { const int col = lane * 4 + 256 * j;
                    const f32x4 gg = *(const f32x4*)(norm2 + col), sh = *(const f32x4*)(MOD + b * 6144 + 3072 + col), sc = *(const f32x4*)(MOD + b * 6144 + 4096 + col);
                    const f32x4 y = v[j] * rs * gg * (sc + 1.f) + sh;
                    *(LAS f32x4*)(ul + rr * 1024 + col) = y;
                    o8[64 * j] = (unsigned long long)cvt_pk_bf16(y.x, y.y) | ((unsigned long long)cvt_pk_bf16(y.z, y.w) << 32); } }
            LDS_WAIT();
            float mine[4] = {0.f, 0.f, 0.f, 0.f}; f32x4 gl[4];
#pragma unroll 1
            for (int c = 0; c < 9; ++c) { f32x4 a[4];
#pragma unroll
                for (int rr = 0; rr < 4; ++rr) a[rr] = (f32x4){0.f, 0.f, 0.f, 0.f};
#pragma unroll
                for (int j = 0; j < 4; ++j) { const int col = lane * 4 + 256 * j; f32x4 w[4];
#pragma unroll
                    for (int i = 0; i < 4; ++i) w[i] = (c < 8) ? *(const f32x4*)(w_exp + (col + i) * 32 + 4 * c) : *(const f32x4*)(w_grp + (col + i) * 4);
#pragma unroll
                    for (int rr = 0; rr < 4; ++rr) { const f32x4 u4 = *(const LAS f32x4*)(ul + rr * 1024 + col);
                        a[rr] += w[0] * u4.x; a[rr] += w[1] * u4.y; a[rr] += w[2] * u4.z; a[rr] += w[3] * u4.w; } }
#pragma unroll
                for (int rr = 0; rr < 4; ++rr) { f32x4 s; s.x = wave_sum(a[rr].x); s.y = wave_sum(a[rr].y); s.z = wave_sum(a[rr].z); s.w = wave_sum(a[rr].w);
                    if (c < 8) { const f32x4 bb = *(const f32x4*)(b_exp + 4 * c); s += bb; const int k = lane - 4 * c; if (k >= 0 && k < 4) mine[rr] = (k == 0 ? s.x : k == 1 ? s.y : k == 2 ? s.z : s.w); }
                    else gl[rr] = s + *(const f32x4*)b_grp; } }
#pragma unroll
            for (int rr = 0; rr < 4; ++rr) {
                int gs = 0; float gm = gl[rr].x;
                if (gl[rr].y > gm) { gm = gl[rr].y; gs = 1; } if (gl[rr].z > gm) { gm = gl[rr].z; gs = 2; } if (gl[rr].w > gm) { gm = gl[rr].w; gs = 3; }
                const float den = __expf(gl[rr].x - gm) + __expf(gl[rr].y - gm) + __expf(gl[rr].z - gm) + __expf(gl[rr].w - gm), pg = 1.f / den;
                int i0 = 0; float v0 = -INFINITY;
#pragma unroll
                for (int e = 0; e < 8; ++e) { const float xv = __shfl(mine[rr], gs * 8 + e); if (xv > v0) { v0 = xv; i0 = e; } }
                int i1 = 0; float v1 = -INFINITY;
#pragma unroll
                for (int e = 0; e < 8; ++e) { const float xv = __shfl(mine[rr], gs * 8 + e); if (e != i0 && xv > v1) { v1 = xv; i1 = e; } }
                const float e1 = __expf(v1 - v0), inv = 1.f / (1.f + e1);
                if (lane == 0) { const int row = rbase + rr, ea = gs * 8 + i0, eb = gs * 8 + i1;
                    Route rt; rt.e0 = ea; rt.e1 = eb; rt.w0 = inv * pg; rt.w1 = e1 * inv * pg; ROUTE[row] = rt;
                    LAS int* lr = lrow + (wave * 8 + p * 4 + rr) * 4; lr[0] = ea; lr[1] = eb;
                    lr[2] = (int)__hip_atomic_fetch_add(lcnt + ea, 1u, __ATOMIC_RELAXED, __HIP_MEMORY_SCOPE_WORKGROUP); lr[3] = (int)__hip_atomic_fetch_add(lcnt + eb, 1u, __ATOMIC_RELAXED, __HIP_MEMORY_SCOPE_WORKGROUP); }
            }
        }
        __syncthreads();
        if (tid < 32) wgbase[tid] = __hip_atomic_fetch_add(ctl + WS_CNT_WORD + tid, lcnt[tid], __ATOMIC_RELAXED, __HIP_MEMORY_SCOPE_AGENT);
        __syncthreads();
        if (tid < 64) { const LAS int* lr = lrow + tid * 4; int* ri = (int*)(ws + WS_RIDX) + (size_t)(vcu * 64 + tid) * 2; ri[0] = lr[2] + (int)wgbase[lr[0]]; ri[1] = lr[3] + (int)wgbase[lr[1]]; }
        __syncthreads();
    }
    SEAM(9);
    if (IN(10)) {
        LAS int* tp = (LAS int*)(lds + TP_OFF);
        moe_tile_prefix(ctl + WS_CNT_WORD, tp, tid);
        int* TOK = (int*)(ws + WS_TOK); float* GATE = (float*)(ws + WS_GATE);
        if (tid < 64) { const int row = vcu * 64 + tid; const Route rt = ROUTE[row]; const int* ri = (const int*)(ws + WS_RIDX) + (size_t)row * 2;
            const int s0 = tp[rt.e0] * 256 + ri[0], s1 = tp[rt.e1] * 256 + ri[1];
            TOK[s0] = row; GATE[s0] = rt.w0; TOK[s1] = row; GATE[s1] = rt.w1; int* sl = (int*)(ws + WS_SLOT) + (size_t)row * 2; sl[0] = s0; sl[1] = s1; }
        if (vcu < 32) { const int e = vcu; for (int s = tp[e] * 256 + (int)ctl[WS_CNT_WORD + e] + tid; s < tp[e + 1] * 256; s += NWAVES * 64) { TOK[s] = 0; GATE[s] = 0.f; } }
    }
    SEAM(10);
    if (IN(11)) {
        LAS int* tp = (LAS int*)(lds + TP_OFF);
        moe_tile_prefix(ctl + WS_CNT_WORD, tp, tid);
        SchedUp S{(const char*)U2, (const char*)(ws + WS_W13), (const int*)(ws + WS_TOK), tp, G, bx}; EpiUp E{(bf16*)(ws + WS_HID), (const float*)(ws + WS_GATE)};
        pg8::gemm_phase<EpiUp, SchedUp, true>(lds, wave, 1024, S, E);
    }
    SEAM(11);
    if (IN(12)) {
        LAS int* tp = (LAS int*)(lds + TP_OFF);
        moe_tile_prefix(ctl + WS_CNT_WORD, tp, tid);
        SchedDown S{(const char*)(ws + WS_HID), (const char*)(ws + WS_W2T), tp, G, bx}; EpiPlain E{(bf16*)(ws + WS_Y), 1024, nullptr};
        pg8::gemm_phase<EpiPlain, SchedDown>(lds, wave, 256, S, E);
    }
    SEAM(12);
    if (IN(13)) {
        const bf16* Y = (const bf16*)(ws + WS_Y);
        f32x4 fg[4];
#pragma unroll
        for (int j = 0; j < 4; ++j) fg[j] = *(const f32x4*)(fnorm + lane * 4 + 256 * j);
        for (int rr = 0; rr < 8; ++rr) { const int row = vcu * 64 + wave * 8 + rr, b = row >> 11;
            const int* sl = (const int*)(ws + WS_SLOT) + (size_t)row * 2; const int s0 = sl[0], s1 = sl[1];
            const f32x4* hr = (const f32x4*)(Hf + (size_t)row * 1024) + lane; const u32x2* y0 = (const u32x2*)(Y + (size_t)s0 * 1024) + lane; const u32x2* y1 = (const u32x2*)(Y + (size_t)s1 * 1024) + lane;
            f32x4 v[4]; float ss = 0.f;
#pragma unroll
            for (int j = 0; j < 4; ++j) { const u32x2 a = y0[64 * j], c2 = y1[64 * j]; const f32x4 g2 = *(const f32x4*)(MOD + b * 6144 + 5120 + lane * 4 + 256 * j);
                v[j] = hr[64 * j] + g2 * (bflo4(a.x, a.y) + bflo4(c2.x, c2.y)); ss += (v[j].x * v[j].x + v[j].y * v[j].y) + (v[j].z * v[j].z + v[j].w * v[j].w); }
            const float rs = rsqrtf(wave_sum(ss) * (1.f / 1024.f) + EPS);
            f32x4* orow = (f32x4*)(args.out + (size_t)row * 1024) + lane;
#pragma unroll
            for (int j = 0; j < 4; ++j) orow[64 * j] = v[j] * rs * fg[j];
        }
    }
#undef IN
#undef SEAM
#undef lane
#undef tid
}

extern "C" void kernel_launch(void* const* d_in, const int* in_sizes, int n_in, void* d_out, int out_size, void* d_ws, size_t ws_size, hipStream_t stream) {
    const float* x = (const float*)d_in[0];
    const float* norm2 = (const float*)d_in[5]; const float* w_in = (const float*)d_in[6]; const float* w_ret_o = (const float*)d_in[7];
    const float* q_norm = (const float*)d_in[8]; const float* kv_norm = (const float*)d_in[9]; const float* w_uq = (const float*)d_in[10]; const float* w_ukv = (const float*)d_in[11];
    const float* w_mla_o = (const float*)d_in[12]; const float* w_out = (const float*)d_in[13]; const float* w_grp = (const float*)d_in[14]; const float* b_grp = (const float*)d_in[15];
    const float* w_exp = (const float*)d_in[16]; const float* b_exp = (const float*)d_in[17]; const float* w1 = (const float*)d_in[18]; const float* w3 = (const float*)d_in[19];
    const float* w2 = (const float*)d_in[20]; const float* fnorm = (const float*)d_in[21];
    unsigned char* ws = (unsigned char*)d_ws; float* out = (float*)d_out;
    float* MOD = (float*)(ws + WS_MOD); float* RSQ = (float*)(ws + WS_RS_Q); float* RSKV = (float*)(ws + WS_RS_KV);
    float* ROPE_MLA = (float*)(ws + WS_ROPE_MLA); Route* ROUTE = (Route*)(ws + WS_ROUTE);
    bf16* XN = (bf16*)(ws + S0); bf16* RQ = (bf16*)(ws + S1); bf16* RK = (bf16*)(ws + S2); bf16* RV = (bf16*)(ws + S3);
    bf16* CQ = (bf16*)(ws + S4); bf16* CKV = (bf16*)(ws + S4 + 12 * MiB); bf16* KPE = (bf16*)(ws + S4 + 20 * MiB);
    bf16* YR = (bf16*)(ws + S5); bf16* RGs = (bf16*)(ws + S1);
    bf16* Qb = (bf16*)(ws + S1 + 0); bf16* KVB = (bf16*)d_out;
    bf16* ATT = (bf16*)(ws + S6); bf16* GR = (bf16*)(ws + S1); bf16* GM = (bf16*)(ws + S2);
    float* H = (float*)d_out; bf16* U2 = (bf16*)(ws + S0);

    static int grid = 0;
    if (grid == 0) {
        int dev = 0, cus = 0, per_cu = 0;
        if (hipGetDevice(&dev) != hipSuccess || hipDeviceGetAttribute(&cus, hipDeviceAttributeMultiprocessorCount, dev) != hipSuccess) { fprintf(stderr, "kernel_launch: device query failed\n"); grid = -1; return; }
        if (hipFuncSetAttribute((const void*)mk_fwd, hipFuncAttributeMaxDynamicSharedMemorySize, LDS_BYTES) != hipSuccess) { fprintf(stderr, "kernel_launch: hipFuncSetAttribute failed\n"); grid = -1; return; }
        if (hipOccupancyMaxActiveBlocksPerMultiprocessor(&per_cu, (const void*)mk_fwd, NWAVES * 64, LDS_BYTES) != hipSuccess || per_cu < 1) { fprintf(stderr, "kernel_launch: occupancy query says %d blocks per CU\n", per_cu); }
        (void)hipGetLastError();
        grid = cus;
        if (grid != 256) fprintf(stderr, "kernel_launch: %d CUs (built for 256)\n", grid);
    }
    if (grid < 0) return;
    (void)hipMemsetAsync(ws + WS_CTL, 0, CTL_ZERO_BYTES, stream);
    MkArgs a{};
    for (int i = 0; i < 22; ++i) a.in[i] = (const float*)d_in[i];
    a.out = out; a.ws = ws;
    int n_launch = 0;
    auto mk = [&](int lo, int hi) { a.ph_lo = lo; a.ph_hi = hi; a.li = n_launch++; hipLaunchKernelGGL(mk_fwd, dim3(grid), dim3(NWAVES * 64), LDS_BYTES, stream, a); };
    mk(0, 14);
}
```
